# Optimizing an MI355X kernel written in HIP

```python
import jax
import jax.numpy as jnp
from jax import lax
import numpy as np

D_MODEL = 1024
BATCH = 4
SEQ = 8192
DEPTH = 4

HEAD_DIM = 64
N_HEADS = 4
BRANCH_W = N_HEADS * HEAD_DIM
N_BRANCH = 4
Q_BLOCK = 128
CMP_BLOCK = 32
SEL_BLOCK = 64
SEL_TOPK = 16
NSA_WINDOW = 512
SWA_WINDOW = 128
SWA_KV_HEADS = 2
RET_CHUNK = 128
RMS_EPS = 1e-6
LN_EPS = 1e-5
NEG_INF = -1e30
TINY = 1e-30
FORCED_SCORE = 1e4

IN_WIDTHS = (
    BRANCH_W, 6 * HEAD_DIM, 3 * N_HEADS, BRANCH_W,
    BRANCH_W, SWA_KV_HEADS * HEAD_DIM, SWA_KV_HEADS * HEAD_DIM, BRANCH_W,
    BRANCH_W, BRANCH_W, BRANCH_W, BRANCH_W,
    BRANCH_W, BRANCH_W, BRANCH_W, BRANCH_W,
)
IN_W = sum(IN_WIDTHS)
IN_OFFSETS = tuple(int(v) for v in np.cumsum(IN_WIDTHS)[:-1])

kernel_name = "hybrid_nsa_swa_stickbreak_retention"


def alibi_slopes(n):
    return jnp.asarray(2.0 ** (-8.0 * (np.arange(n) + 1) / n), dtype=jnp.float32)


def rms_norm(x, g):
    xf = x.astype(jnp.float32)
    y = xf * lax.rsqrt(jnp.mean(xf * xf, axis=-1, keepdims=True) + RMS_EPS)
    return (y * g.astype(jnp.float32)).astype(x.dtype)


def masked_softmax(s, mask, sink=None):
    s = jnp.where(mask, s, NEG_INF)
    m = jnp.max(s, axis=-1, keepdims=True)
    if sink is not None:
        m = jnp.maximum(m, sink)
    e = jnp.where(mask, jnp.exp(s - m), 0.0)
    den = jnp.sum(e, axis=-1, keepdims=True)
    if sink is not None:
        den = den + jnp.exp(sink - m)
    return e / jnp.maximum(den, TINY)


def band_windows(k, n_prev):
    B, S = k.shape[:2]
    nblk = S // Q_BLOCK
    pad = [(0, 0), (n_prev * Q_BLOCK, 0)] + [(0, 0)] * (k.ndim - 2)
    kp = jnp.pad(k, pad).reshape(B, nblk + n_prev, Q_BLOCK, *k.shape[2:])
    return jnp.concatenate([kp[:, j:j + nblk] for j in range(n_prev + 1)], axis=2)


def banded_attention(q, k, v, window, slopes, sink=None):
    B, S, H, Dh = q.shape
    Hkv = k.shape[2]
    G = H // Hkv
    nblk = S // Q_BLOCK
    n_prev = -(-(window - 1) // Q_BLOCK)
    K = (n_prev + 1) * Q_BLOCK
    kw = band_windows(k, n_prev)
    vw = band_windows(v, n_prev)
    qb = q.reshape(B, nblk, Q_BLOCK, Hkv, G, Dh)
    s = jnp.einsum("bnqhgd,bnkhd->bnhgqk", qb, kw).astype(jnp.float32) * Dh ** -0.5
    rel = jnp.arange(Q_BLOCK)[:, None] + n_prev * Q_BLOCK - jnp.arange(K)[None, :]
    kpos = jnp.arange(nblk)[:, None] * Q_BLOCK - n_prev * Q_BLOCK + jnp.arange(K)[None, :]
    mask = ((rel >= 0) & (rel < window))[None] & (kpos >= 0)[:, None, :]
    s = s - slopes.reshape(Hkv, G, 1, 1) * rel.astype(jnp.float32)
    sk = None if sink is None else sink.astype(jnp.float32).reshape(1, 1, Hkv, G, 1, 1)
    p = masked_softmax(s, mask[None, :, None, None], sk)
    o = jnp.einsum("bnhgqk,bnkhd->bnqhgd", p.astype(v.dtype), vw)
    return o.reshape(B, S, H, Dh)


def nsa_attention(q, kv, gate_logits, pos_emb, w1, w2):
    B, S, H, Dh = q.shape
    k_cmp, v_cmp, k_sel, v_sel, k_win, v_win = jnp.split(kv, 6, axis=-1)
    slopes = alibi_slopes(H)
    scale = Dh ** -0.5
    t = jnp.arange(S)

    nc = S // CMP_BLOCK
    def compress(z, j):
        zb = z.reshape(B, nc, CMP_BLOCK, Dh) + pos_emb[j]
        return jax.nn.silu(zb.reshape(B, nc, CMP_BLOCK * Dh) @ w1[j]) @ w2[j]
    kc = compress(k_cmp, 0)
    vc = compress(v_cmp, 1)
    blk_end = jnp.arange(nc) * CMP_BLOCK + CMP_BLOCK - 1
    dist = t[:, None] - blk_end[None, :]
    s = jnp.einsum("bshd,bcd->bhsc", q, kc).astype(jnp.float32) * scale
    s = s - slopes[:, None, None] * dist.astype(jnp.float32)
    p_cmp = masked_softmax(s, dist >= 0)
    o_cmp = jnp.einsum("bhsc,bcd->bshd", p_cmp.astype(vc.dtype), vc)

    ns = S // SEL_BLOCK
    ratio = SEL_BLOCK // CMP_BLOCK
    imp = p_cmp.sum(axis=1).reshape(B, S, ns, ratio).sum(axis=-1)
    blk = jnp.arange(ns)[None, :]
    cur = (t // SEL_BLOCK)[:, None]
    future = blk * SEL_BLOCK > t[:, None]
    forced = (blk == 0) | (blk == cur) | (blk == cur - 1)
    imp = jnp.where(forced, FORCED_SCORE, jnp.where(future, -1.0, imp))
    topk = min(SEL_TOPK, ns)
    _, idx = lax.top_k(imp, topk)

    kb = k_sel.reshape(B, ns, SEL_BLOCK, Dh)
    vb = v_sel.reshape(B, ns, SEL_BLOCK, Dh)
    nq = S // Q_BLOCK
    qs = q.reshape(B, nq, Q_BLOCK, H, Dh).swapaxes(0, 1)
    ids = idx.reshape(B, nq, Q_BLOCK, topk).swapaxes(0, 1)
    qpos = t.reshape(nq, Q_BLOCK)
    bidx = jnp.arange(B)[:, None, None]
    n_keys = topk * SEL_BLOCK

    def sel_block(args):
        qi, ii, pi = args
        kg = kb[bidx, ii].reshape(B, Q_BLOCK, n_keys, Dh)
        vg = vb[bidx, ii].reshape(B, Q_BLOCK, n_keys, Dh)
        kpos = (ii[..., None] * SEL_BLOCK + jnp.arange(SEL_BLOCK)).reshape(B, Q_BLOCK, n_keys)
        d = pi[None, :, None] - kpos
        sc = jnp.einsum("bqhd,bqkd->bhqk", qi, kg).astype(jnp.float32) * scale
        sc = sc - slopes[:, None, None] * d[:, None].astype(jnp.float32)
        pr = masked_softmax(sc, (d >= 0)[:, None])
        return jnp.einsum("bhqk,bqkd->bqhd", pr.astype(vg.dtype), vg)

    o_sel = lax.map(sel_block, (qs, ids, qpos)).swapaxes(0, 1).reshape(B, S, H, Dh)

    o_win = banded_attention(q, k_win[:, :, None], v_win[:, :, None], NSA_WINDOW, slopes)

    g = jax.nn.sigmoid(gate_logits.astype(jnp.float32)).reshape(B, S, H, 3).astype(q.dtype)
    return g[..., 0:1] * o_cmp + g[..., 1:2] * o_sel + g[..., 2:3] * o_win


def stick_breaking_attention(q, k, v):
    B, S, H, Dh = q.shape
    nq = S // Q_BLOCK
    qs = q.reshape(B, nq, Q_BLOCK, H, Dh).swapaxes(0, 1)
    qpos = jnp.arange(S).reshape(nq, Q_BLOCK)
    kpos = jnp.arange(S)
    scale = Dh ** -0.5

    def one_block(args):
        qi, pi = args
        z = jnp.einsum("bqhd,bkhd->bhqk", qi, k).astype(jnp.float32) * scale
        mask = kpos[None, :] < pi[:, None]
        log_beta = jax.nn.log_sigmoid(z)
        log_1m = jnp.where(mask, jax.nn.log_sigmoid(-z), 0.0)
        suffix = lax.cumsum(log_1m, axis=3, reverse=True) - log_1m
        a = jnp.where(mask, jnp.exp(log_beta + suffix), 0.0)
        return jnp.einsum("bhqk,bkhd->bqhd", a.astype(v.dtype), v)

    return lax.map(one_block, (qs, qpos)).swapaxes(0, 1).reshape(B, S, H, Dh)


def retention(q, k, v):
    B, S, H, Dh = q.shape
    C = RET_CHUNK
    n = S // C
    log_g = jnp.log(1.0 - jnp.asarray(2.0 ** (-5.0 - np.arange(H)), dtype=jnp.float32))
    qc = (q.astype(jnp.float32) * Dh ** -0.5).reshape(B, n, C, H, Dh)
    kc = k.astype(jnp.float32).reshape(B, n, C, H, Dh)
    vc = v.astype(jnp.float32).reshape(B, n, C, H, Dh)
    i = jnp.arange(C)
    diff = (i[:, None] - i[None, :]).astype(jnp.float32)
    dmat = jnp.where(diff >= 0, jnp.exp(log_g[:, None, None] * jnp.maximum(diff, 0.0)), 0.0)
    s = jnp.einsum("bnihd,bnjhd->bnhij", qc, kc) * dmat
    intra = jnp.einsum("bnhij,bnjhd->bnihd", s, vc)
    zeta = jnp.exp(log_g[:, None] * (C - 1 - i)[None, :].astype(jnp.float32))
    u = jnp.einsum("bnjhd,bnjhe,hj->nbhde", kc, vc, zeta)
    g_chunk = jnp.exp(log_g * C)[None, :, None, None]

    def step(r, u_n):
        return r * g_chunk + u_n, r

    _, r_prev = lax.scan(step, jnp.zeros((B, H, Dh, Dh), jnp.float32), u)
    xi = jnp.exp(log_g[:, None] * (i + 1)[None, :].astype(jnp.float32))
    cross = jnp.einsum("bnihd,nbhde,hi->bnihe", qc, r_prev, xi)
    o = (intra + cross).reshape(B, S, H, Dh)
    mu = jnp.mean(o, axis=-1, keepdims=True)
    var = jnp.mean((o - mu) ** 2, axis=-1, keepdims=True)
    return ((o - mu) * lax.rsqrt(var + LN_EPS)).astype(q.dtype)


def hybrid_layer(x, c, w_ada, b_ada, norm_g, w_in, cmp_pos, cmp_w1, cmp_w2, sink, w_merge, w_br, w_out):
    B, S, _ = x.shape
    mod = (jax.nn.silu(c) @ w_ada + b_ada)[:, None, :]
    shift, scale, gate = jnp.split(mod, 3, axis=-1)
    h = rms_norm(x, norm_g) * (1.0 + scale) + shift
    (a_q, a_kv, a_g, a_z, b_q, b_k, b_v, b_z,
     c_q, c_k, c_v, c_z, d_q, d_k, d_v, d_z) = jnp.split(h @ w_in, IN_OFFSETS, axis=-1)

    def heads(z):
        return z.reshape(B, S, -1, HEAD_DIM)

    y_a = nsa_attention(heads(a_q), a_kv, a_g, cmp_pos, cmp_w1, cmp_w2)
    y_b = banded_attention(heads(b_q), heads(b_k), heads(b_v), SWA_WINDOW, alibi_slopes(N_HEADS), sink)
    y_c = stick_breaking_attention(heads(c_q), heads(c_k), heads(c_v))
    y_d = retention(heads(d_q), heads(d_k), heads(d_v))

    branches = ((y_a, a_z), (y_b, b_z), (y_c, c_z), (y_d, d_z))
    merged = None
    for i, (y, z) in enumerate(branches):
        yi = y.reshape(B, S, BRANCH_W) * jax.nn.silu(z)
        term = jax.nn.sigmoid(h @ w_merge[i]) * (yi @ w_br[i])
        merged = term if merged is None else merged + term
    return x + gate * (merged @ w_out)


def setup_inputs(seed: int = 0) -> dict:
    key = jax.random.key(seed)
    ks = jax.random.split(key, 14)
    D = D_MODEL
    f32 = jnp.float32

    def nrm(k, shape, fan):
        return jax.random.normal(k, shape, f32) * fan ** -0.5

    return {
        "x": jax.random.normal(ks[0], (BATCH, SEQ, D), f32),
        "c": jax.random.normal(ks[1], (BATCH, D), f32),
        "w_ada": nrm(ks[2], (DEPTH, D, 3 * D), D) * 0.5,
        "b_ada": 0.02 * jax.random.normal(ks[3], (DEPTH, 3 * D), f32),
        "norm_g": 1.0 + 0.05 * jax.random.normal(ks[4], (DEPTH, D), f32),
        "w_in": nrm(ks[5], (DEPTH, D, IN_W), D),
        "cmp_pos": 0.1 * jax.random.normal(ks[6], (DEPTH, 2, CMP_BLOCK, HEAD_DIM), f32),
        "cmp_w1": nrm(ks[7], (DEPTH, 2, CMP_BLOCK * HEAD_DIM, HEAD_DIM), CMP_BLOCK * HEAD_DIM),
        "cmp_w2": nrm(ks[8], (DEPTH, 2, HEAD_DIM, HEAD_DIM), HEAD_DIM),
        "sink": 0.5 * jax.random.normal(ks[9], (DEPTH, N_HEADS), f32),
        "w_merge": nrm(ks[10], (DEPTH, N_BRANCH, D, D), D),
        "w_br": nrm(ks[11], (DEPTH, N_BRANCH, BRANCH_W, D), BRANCH_W),
        "w_out": nrm(ks[12], (DEPTH, D, D), D),
        "final_g": 1.0 + 0.05 * jax.random.normal(ks[13], (D,), f32),
    }


def reference(x, c, w_ada, b_ada, norm_g, w_in, cmp_pos, cmp_w1, cmp_w2, sink, w_merge, w_br, w_out, final_g):
    for l in range(DEPTH):
        x = hybrid_layer(x, c, w_ada[l], b_ada[l], norm_g[l], w_in[l], cmp_pos[l], cmp_w1[l], cmp_w2[l],
                         sink[l], w_merge[l], w_br[l], w_out[l])
    return rms_norm(x, final_g)
```

```cpp
#include <hip/hip_runtime.h>
#include <cstdio>
#include <cstdint>

#define GAS __attribute__((address_space(1)))
#define LAS __attribute__((address_space(3)))
typedef unsigned short bf16;
typedef unsigned u32x4 __attribute__((ext_vector_type(4)));
typedef unsigned u32x2 __attribute__((ext_vector_type(2)));
typedef float f32x4 __attribute__((ext_vector_type(4)));
typedef float f32x2 __attribute__((ext_vector_type(2)));
typedef short bf16x8 __attribute__((ext_vector_type(8)));

#ifndef DBG_REP
#define DBG_REP 0
#endif
#define NREP(k) (((DBG_REP >> (k)) & 1) ? 2 : 1)
#ifndef XPRE
#define XPRE (DBG_REP == 0)
#endif
#ifndef WGM_G1
#define WGM_G1 4
#endif
#ifndef WGM_POST_V
#define WGM_POST_V 8
#endif
#ifndef WGM_OUT
#define WGM_OUT 8
#endif
#ifndef MIX_MERGE
#define MIX_MERGE 1
#endif
#ifndef MK_N_LAUNCHES
#define MK_N_LAUNCHES 1
#endif

constexpr int DM = 1024, NBATCH = 4, SEQ = 8192, DEPTH = 4, MROWS = NBATCH * SEQ;
constexpr int INW = 3724, PW = 3840;
constexpr int A_Q = 0, A_KV = 256, A_Z = 640, B_Q = 896, B_K = 1152, B_V = 1280, B_Z = 1408;
constexpr int C_Q = 1664, C_K = 1920, C_V = 2176, C_Z = 2432, D_Q = 2688, D_K = 2944, D_V = 3200, D_Z = 3456, A_G = 3712;
constexpr int KCAT = 1280;
constexpr int NWAVES = 8, NTHREADS = 512;
constexpr int PH_PER_LAYER = 6, NPH = 3 + DEPTH * PH_PER_LAYER;

constexpr size_t MiB = 1u << 20;
constexpr size_t WS_CTL = 0, CTL_ZERO_BYTES = 65536;
constexpr size_t WS_MOD = 1 * MiB;
constexpr size_t WS_KC = 2 * MiB, WS_VC = 2 * MiB + 262144;
constexpr size_t WS_KCB = 2 * MiB + 524288, WS_VCB = 2 * MiB + 655360;
constexpr size_t WS_WIN = 4 * MiB;
constexpr size_t WS_WCAT = 34 * MiB;
constexpr size_t WS_WO = 74 * MiB;
constexpr size_t WS_XN = 82 * MiB;
constexpr size_t WS_Y = 146 * MiB;
constexpr size_t WS_U = 210 * MiB;
constexpr size_t WS_P = 226 * MiB;
constexpr size_t WS_MERGED = WS_P;
constexpr size_t WS_XF = WS_P + 64 * MiB;
constexpr size_t WS_SCR = WS_P + 64 * MiB;
constexpr size_t WS_W1T = 466 * MiB;
constexpr size_t WS_B1P = 3 * MiB;
constexpr size_t WS_GS = 3 * MiB + 65536;
constexpr size_t WS_SW = 3 * MiB + 131072;
constexpr size_t WS_SWM = 3 * MiB + 393216;
constexpr size_t WS_SSQ = 468 * MiB;
constexpr size_t WS_END = 469 * MiB;
constexpr int CW_TMO = 0, CW_BAR = 4096, CW_CNT = 8192;

constexpr int RING_BYTES = 131072;
constexpr int LDSCTL_OFF = RING_BYTES, MISC_OFF = LDSCTL_OFF + 320;
constexpr int LDS_BYTES = 163840;
constexpr int L_GSLOT = 132096, L_EPT = L_GSLOT + 24576;

__device__ __forceinline__ float bf2f(bf16 u) { return __uint_as_float((unsigned)u << 16); }
__device__ __forceinline__ float bflo(unsigned w) { return __uint_as_float(w << 16); }
__device__ __forceinline__ float bfhi(unsigned w) { return __uint_as_float(w & 0xffff0000u); }
__device__ __forceinline__ unsigned f2bf(float f) { unsigned u = __float_as_uint(f); return (u + 0x7fffu + ((u >> 16) & 1u)) >> 16; }
__device__ __forceinline__ unsigned pk2(float lo, float hi) { return f2bf(lo) | (f2bf(hi) << 16); }
typedef __bf16 bf16x2_t __attribute__((ext_vector_type(2)));
__device__ __forceinline__ unsigned cvt_pk_bf16(float lo, float hi) { const f32x2 v = {lo, hi}; const bf16x2_t b = __builtin_convertvector(v, bf16x2_t); return __builtin_bit_cast(unsigned, b); }
template <int M> __device__ __forceinline__ float xshfl(float v) {
    static_assert(M == 1 || M == 2 || M == 4 || M == 8 || M == 16, "xshfl mask");
    if (M == 1) return __uint_as_float(__builtin_amdgcn_update_dpp(0, __float_as_uint(v), 0xB1, 0xF, 0xF, true));
    if (M == 2) return __uint_as_float(__builtin_amdgcn_update_dpp(0, __float_as_uint(v), 0x4E, 0xF, 0xF, true));
    return __uint_as_float(__builtin_amdgcn_ds_swizzle(__float_as_uint(v), (M << 10) | 0x1F));
}
__device__ __forceinline__ float xsum32_(float v) { auto rr = __builtin_amdgcn_permlane32_swap(__float_as_uint(v), __float_as_uint(v), false, false); return __uint_as_float(rr[0]) + __uint_as_float(rr[1]); }
__device__ __forceinline__ float xmax32_(float v) { auto rr = __builtin_amdgcn_permlane32_swap(__float_as_uint(v), __float_as_uint(v), false, false); return fmaxf(__uint_as_float(rr[0]), __uint_as_float(rr[1])); }
__device__ __forceinline__ float wave_sum(float v) { v += xshfl<1>(v); v += xshfl<2>(v); v += xshfl<4>(v); v += xshfl<8>(v); v += xshfl<16>(v); return xsum32_(v); }
__device__ __forceinline__ float wave_max(float v) { v = fmaxf(v, xshfl<1>(v)); v = fmaxf(v, xshfl<2>(v)); v = fmaxf(v, xshfl<4>(v)); v = fmaxf(v, xshfl<8>(v)); v = fmaxf(v, xshfl<16>(v)); return xmax32_(v); }
__device__ __forceinline__ int lane_id_now() { unsigned z = 0u; asm volatile("" : "+v"(z)); return (int)__builtin_amdgcn_mbcnt_hi(~0u, __builtin_amdgcn_mbcnt_lo(~0u, z)); }
__device__ __forceinline__ float sigmoidf_(float x) { return __builtin_amdgcn_rcpf(1.f + __expf(-x)); }
__device__ __forceinline__ float siluf_(float x) { return x * sigmoidf_(x); }
#define LDS_WAIT() asm volatile("s_waitcnt lgkmcnt(0)" ::: "memory")
#define VM_WAIT() asm volatile("s_waitcnt vmcnt(0)" ::: "memory")

__device__ __forceinline__ void publish_count(unsigned* cnt, bool leader) {
    asm volatile("s_waitcnt vmcnt(0)" ::: "memory"); __syncthreads();
    if (leader) (void)__hip_atomic_fetch_add(cnt, 1u, __ATOMIC_RELAXED, __HIP_MEMORY_SCOPE_AGENT);
}
__device__ __forceinline__ void wait_count(unsigned* cnt, unsigned expected, int wave) {
    if (wave == 0) { unsigned spins = 0;
        while ((unsigned)__builtin_amdgcn_readfirstlane((int)__hip_atomic_load(cnt, __ATOMIC_RELAXED, __HIP_MEMORY_SCOPE_AGENT)) < expected) { __builtin_amdgcn_s_sleep(2); if (++spins > (1u << 22)) break; }
        __builtin_amdgcn_fence(__ATOMIC_ACQUIRE, "agent"); asm volatile("s_waitcnt vmcnt(0)" ::: "memory"); }
    __syncthreads();
}
__device__ __forceinline__ void st_wt(float* p, float v) { __hip_atomic_store(p, v, __ATOMIC_RELAXED, __HIP_MEMORY_SCOPE_AGENT); }
__device__ __forceinline__ void st_wt(unsigned* p, unsigned v) { __hip_atomic_store(p, v, __ATOMIC_RELAXED, __HIP_MEMORY_SCOPE_AGENT); }

#define XB_TMO      128
#define XB_XCNT(j)  (256  + 64 * (j))
#define XB_XSUB(j)  (1280 + 64 * (j))
#define XB_XGEN(j)  (2304 + 64 * (j))
#define XB_TOP      3328
#define XB_TOPGEN   3392
#define XCD_BAR_WORDS 3456
#define XB_SPIN_CAP (1u << 18)
__device__ __forceinline__ unsigned xb_ld(unsigned* p)              { return __hip_atomic_load(p, __ATOMIC_RELAXED, __HIP_MEMORY_SCOPE_AGENT); }
__device__ __forceinline__ unsigned xb_add(unsigned* p, unsigned v) { return __hip_atomic_fetch_add(p, v, __ATOMIC_RELAXED, __HIP_MEMORY_SCOPE_AGENT); }
__device__ __forceinline__ unsigned xb_xcc_id() { return (unsigned)__builtin_amdgcn_s_getreg((3 << 11) | 20) & 0xFu; }
#define XB_SPIN(cond, bar) do { unsigned _sp = 0; while (cond) { __builtin_amdgcn_s_sleep(1); \
    if ((++_sp & 255u) == 0u) { if (xb_ld(&(bar)[XB_TMO])) break; if (_sp > XB_SPIN_CAP) { atomicAdd(&(bar)[XB_TMO], 1u); break; } } } } while (0)
struct XcdBarrier { unsigned* bar; unsigned x; volatile LAS unsigned* st; int wave; };
__device__ __forceinline__ XcdBarrier xcd_barrier_post(unsigned* bar, volatile LAS unsigned* st) {
    XcdBarrier b; b.bar = bar; b.x = xb_xcc_id(); b.st = st; b.wave = 0;
    if (threadIdx.x == 0) (void)xb_add(&bar[XB_XCNT(b.x)], 1u);
    return b;
}
__device__ __forceinline__ void xcd_barrier_complete(unsigned* bar, unsigned x, unsigned& nloc, unsigned& nx) {
    const unsigned G = gridDim.x * gridDim.y * gridDim.z;
    unsigned sum, cnt, mine, sp = 0u;
    for (;;) {
        sum = 0u; cnt = 0u; mine = 0u;
#pragma unroll
        for (unsigned j = 0; j < 16; ++j) { const unsigned c = xb_ld(&bar[XB_XCNT(j)]); sum += c; cnt += (c > 0u) ? 1u : 0u; mine = (j == x) ? c : mine; }
        if (sum == G) break;
        __builtin_amdgcn_s_sleep(1);
        if ((++sp & 255u) == 0u) { if (xb_ld(&bar[XB_TMO])) break; if (sp > XB_SPIN_CAP) { atomicAdd(&bar[XB_TMO], 1u); break; } }
    }
    nloc = mine > 0u ? mine : 1u; nx = cnt > 0u ? cnt : 1u;
}
__device__ __forceinline__ void xcd_barrier(const XcdBarrier& b) {
    asm volatile("s_waitcnt vmcnt(0)" ::: "memory");
    __syncthreads();
    if (b.wave == 0 && lane_id_now() == 0) {
        unsigned* bar = b.bar;
        __builtin_amdgcn_s_waitcnt(0);
        unsigned nloc = b.st[0], nx = b.st[1];
        if (nloc == 0u) { xcd_barrier_complete(bar, b.x, nloc, nx); b.st[0] = nloc; b.st[1] = nx; }
        const unsigned old = xb_add(&bar[XB_XSUB(b.x)], 1u);
        const unsigned gen = old / nloc;
        if (old + 1u == (gen + 1u) * nloc) {
            __builtin_amdgcn_fence(__ATOMIC_RELEASE, "agent");
            asm volatile("s_waitcnt vmcnt(0)" ::: "memory");
            const unsigned og = xb_add(&bar[XB_TOP], 1u);
            const unsigned tg = og / nx;
            if (og + 1u == (tg + 1u) * nx) xb_add(&bar[XB_TOPGEN], 1u);
            else XB_SPIN(xb_ld(&bar[XB_TOPGEN]) == tg, bar);
            __builtin_amdgcn_fence(__ATOMIC_ACQUIRE, "agent");
            xb_add(&bar[XB_XGEN(b.x)], 1u);
            asm volatile("s_waitcnt vmcnt(0)" ::: "memory");
        } else {
            XB_SPIN(xb_ld(&bar[XB_XGEN(b.x)]) == gen, bar);
            __builtin_amdgcn_fence(__ATOMIC_ACQUIRE, "agent");
            asm volatile("s_waitcnt vmcnt(0)" ::: "memory");
        }
    }
    __syncthreads();
}

namespace pg8 {
constexpr int BM = 256, BK = 64, HALF = 128, HTB = HALF * BK * 2, STAGE_BYTES = 8 * HTB, NXCD = 8;
__host__ __device__ __forceinline__ int lds_byte(int r, int c) { const int st = (r >> 4) * 2 + (c >> 5), rr = r & 15, cc = c & 31, ob = rr * 64 + cc * 2; return st * 1024 + (ob ^ (((ob >> 9) & 1) << 5)); }
__host__ __device__ __forceinline__ void stage_rc(int b, int& R, int& C) { const int st = b / 1024, sb = b % 1024, swz = sb ^ (((sb >> 9) & 1) << 5); R = (st >> 1) * 16 + swz / 64; C = (st & 1) * 32 + (swz % 64) / 2; }
__host__ __device__ __forceinline__ int perm32(int rho) { const int n = rho >> 4, i = rho & 15; return 8 * (i >> 2) + 4 * n + (i & 3); }

struct Unit { int pm, pn; const char* A; const char* B; int nt; int kind; };

template <int WGM, int nM, int nN> __device__ __forceinline__ void tile_of(int L, int& pm, int& pn) {
    const int nwg = nM * nN; int wgid = L;
    { const int q = nwg / NXCD, r = nwg % NXCD, xcd = wgid % NXCD, off = wgid / NXCD; wgid = (xcd < r ? xcd * (q + 1) : r * (q + 1) + (xcd - r) * q) + off; }
    const int nig = WGM * nN, gid = wgid / nig, fm = gid * WGM, gsz = (nM % WGM == 0) ? WGM : ((nM - fm) < WGM ? (nM - fm) : WGM);
    pm = fm + ((wgid % nig) % gsz); pn = (wgid % nig) / gsz;
}
template <int WGM_, int nM, int nN> struct PlainOrderT {
    const char* A; const char* Bt; int nt, G, c; size_t lda, ldb;
    __device__ __forceinline__ bool next(int i, Unit& u) const {
        const long L = (long)i * G + c; if (L >= (long)nM * nN) return false;
        tile_of<WGM_, nM, nN>((int)L, u.pm, u.pn);
        u.A = A + (size_t)u.pm * BM * lda * 2; u.B = Bt + (size_t)u.pn * BM * ldb * 2; u.nt = nt; u.kind = 0; return true;
    }
};
constexpr int WGM_POST = WGM_POST_V;
struct PostOrder {
    static constexpr int nM = MROWS / 256, nN = DM / 256; const char* XN; const char* Y; const char* Wcat; int G, c;
    __device__ __forceinline__ bool next(int ui, Unit& u) const {
        const int round = ui >> 3, sub = ui & 7, i = sub >> 1, kind = sub & 1;
        const long L = (long)round * G + c; if (L >= (long)nM * nN) return false;
        tile_of<WGM_POST, nM, nN>((int)L, u.pm, u.pn);
        const char* wb = Wcat + ((size_t)i * DM + (size_t)u.pn * BM) * KCAT * 2;
        if (kind == 0) { u.A = XN + (size_t)u.pm * BM * DM * 2; u.B = wb; u.nt = 16; }
        else           { u.A = Y + ((size_t)u.pm * BM * DM + 256 * i) * 2; u.B = wb + 1024 * 2; u.nt = 4; }
        u.kind = sub; return true;
    }
};

__device__ __forceinline__ float row_rstd(const float* ssq, int row) { const f32x4 q = *(const f32x4*)(ssq + (size_t)row * 4); return rsqrtf(((q.x + q.y) + (q.z + q.w)) * (1.f / DM) + 1e-6f); }
struct EpiP {
    static constexpr bool PERM = true; struct Carry {}; static __device__ __forceinline__ bool keeps_acc(int) { return false; }
    bf16* O; const float* ssq; const float* sw; LAS unsigned char* ept_;
    __device__ __forceinline__ void prefetch(const Unit& u, int wid, int ui) const {
        const int ln = lane_id_now(); LAS unsigned char* e = ept_ + (ui & 1) * 8192;
        if (wid < 4) __builtin_amdgcn_global_load_lds((const unsigned*)(ssq + ((size_t)u.pm * BM + wid * 64 + ln) * 4), (LAS unsigned*)(e + wid * 1024), 16, 0, 0);
        else if (wid == 4) __builtin_amdgcn_global_load_lds((const unsigned*)(sw + (size_t)(u.pm >> 5) * PW + u.pn * BM + ln * 4), (LAS unsigned*)(e + 4096), 16, 0, 0);
    }
    __device__ __forceinline__ void operator()(f32x4 (&acc)[2][2][4][2], const Unit& u, int wr, int wc, int fr, int fq, Carry&, int ui) const {
        asm volatile("" : "+v"(fr));
        const LAS unsigned char* ept = ept_ + (ui & 1) * 8192;
        const int row0 = u.pm * BM + wr * 64 + fr, col0 = u.pn * BM + wc * 32 + 8 * fq; const LAS float* swl = (const LAS float*)(ept + 4096) + wc * 32 + 8 * fq;
        const f32x4 s00 = *(const LAS f32x4*)(swl), s01 = *(const LAS f32x4*)(swl + 4), s10 = *(const LAS f32x4*)(swl + HALF), s11 = *(const LAS f32x4*)(swl + HALF + 4);
#pragma unroll
        for (int ai = 0; ai < 2; ++ai)
#pragma unroll
            for (int m = 0; m < 4; ++m) { const int row = row0 + ai * HALF + m * 16; const f32x4 q = *(const LAS f32x4*)(ept + (wr * 64 + fr + ai * HALF + m * 16) * 16);
                const float r = rsqrtf(((q.x + q.y) + (q.z + q.w)) * (1.f / DM) + 1e-6f); bf16* rowp = O + (size_t)row * PW + col0;
#pragma unroll
                for (int bj = 0; bj < 2; ++bj) { const f32x4 v0 = acc[ai][bj][m][0] * r + (bj ? s10 : s00), v1 = acc[ai][bj][m][1] * r + (bj ? s11 : s01);
                    u32x4 w; w.x = cvt_pk_bf16(v0[0], v0[1]); w.y = cvt_pk_bf16(v0[2], v0[3]); w.z = cvt_pk_bf16(v1[0], v1[1]); w.w = cvt_pk_bf16(v1[2], v1[3]);
                    *(u32x4*)(rowp + bj * HALF) = w; } }
    }
};
struct EpiPost {
    static constexpr bool PERM = true;
    static constexpr int NKR = 9, NKL = 3;
    struct Carry { u32x4 k[NKR]; };
    bf16* O; u32x4* scr; const float* ssq; const float* swm; LAS unsigned char* gl_; int tid_;
    static __device__ __forceinline__ bool keeps_acc(int kind) { return (kind & 1) == 0; }
    __device__ __forceinline__ void prefetch(const Unit& u, int wid, int) const {
        if (u.kind & 1) return;
        const int ln = lane_id_now(); LAS unsigned char* ept = gl_ + (L_EPT - L_GSLOT);
        if (wid < 4) __builtin_amdgcn_global_load_lds((const unsigned*)(ssq + ((size_t)u.pm * BM + wid * 64 + ln) * 4), (LAS unsigned*)(ept + wid * 1024), 16, 0, 0);
        else if (wid == 4) __builtin_amdgcn_global_load_lds((const unsigned*)(swm + (size_t)(u.pm >> 5) * 4096 + (u.kind >> 1) * DM + u.pn * BM + ln * 4), (LAS unsigned*)(ept + 4096), 16, 0, 0);
    }
    __device__ __forceinline__ void operator()(f32x4 (&acc)[2][2][4][2], const Unit& u, int wr, int wc, int fr, int fq, Carry& cy, int) const {
        int tid = ((wr * 4 + wc) << 6) | (fq << 4) | fr; const int i = u.kind >> 1;
        asm volatile("" : "+v"(tid), "+v"(fr));
        u32x4* sg = scr + ((tid >> 6) << 10) + (tid & 63);
        LAS u32x4* gl = (LAS u32x4*)(gl_ + tid * 16);
        const int row0 = u.pm * BM + wr * 64 + fr, col0 = u.pn * BM + wc * 32 + 8 * fq;
        u32x4 cin[16 - NKR];
        if ((u.kind & 1) == 0) {
            const LAS unsigned char* ept = gl_ + (L_EPT - L_GSLOT); const LAS float* swb = (const LAS float*)(ept + 4096) + wc * 32 + 8 * fq; const LAS float* sq = (const LAS float*)ept + (wr * 64 + fr) * 4;
            f32x4 q4[4];
#pragma unroll
            for (int k = 0; k < 4; ++k) q4[k] = *(const LAS f32x4*)(sq + k * 64);
            const f32x4 sw0a = *(const LAS f32x4*)(swb), sw0b = *(const LAS f32x4*)(swb + 4), sw1a = *(const LAS f32x4*)(swb + HALF), sw1b = *(const LAS f32x4*)(swb + HALF + 4);
            float rr[4];
#pragma unroll
            for (int sl = 0; sl < 16; ++sl) { const int ai = sl >> 3, bj = (sl >> 2) & 1, m = sl & 3;
                if (sl == 0 || sl == 8) {
#pragma unroll
                    for (int k = 0; k < 4; ++k) rr[k] = rsqrtf(((q4[k].x + q4[k].y) + (q4[k].z + q4[k].w)) * (1.f / DM) + 1e-6f); }
                if (sl == 2) {
#pragma unroll
                    for (int k = 0; k < 4; ++k) q4[k] = *(const LAS f32x4*)(sq + HALF * 4 + k * 64);
#pragma unroll
                    for (int s2 = NKR + NKL; s2 < 16; ++s2) cin[s2 - NKR] = sg[s2 * 64];
                    asm volatile("" ::: "memory"); }
                if (sl >= NKR && sl < NKR + NKL) cin[sl - NKR] = gl[(sl - NKR) * 512];
                const float r = rr[m];
                const f32x4 sa = bj ? sw1a : sw0a, sb = bj ? sw1b : sw0b; const f32x4 v0 = acc[ai][bj][m][0], v1 = acc[ai][bj][m][1];
                const u32x4 pin = (sl < NKR) ? cy.k[sl < NKR ? sl : 0] : cin[sl < NKR ? 0 : sl - NKR]; const u32x4 pq = (i > 0) ? pin : (u32x4){0u, 0u, 0u, 0u};
                float g[8]; g[0] = fmaxf(sigmoidf_(v0[0] * r + sa[0]), 0x1p-60f); g[1] = fmaxf(sigmoidf_(v0[1] * r + sa[1]), 0x1p-60f); g[2] = fmaxf(sigmoidf_(v0[2] * r + sa[2]), 0x1p-60f); g[3] = fmaxf(sigmoidf_(v0[3] * r + sa[3]), 0x1p-60f);
                g[4] = fmaxf(sigmoidf_(v1[0] * r + sb[0]), 0x1p-60f); g[5] = fmaxf(sigmoidf_(v1[1] * r + sb[1]), 0x1p-60f); g[6] = fmaxf(sigmoidf_(v1[2] * r + sb[2]), 0x1p-60f); g[7] = fmaxf(sigmoidf_(v1[3] * r + sb[3]), 0x1p-60f);
                u32x4 w; w.x = cvt_pk_bf16(g[0], g[1]); w.y = cvt_pk_bf16(g[2], g[3]); w.z = cvt_pk_bf16(g[4], g[5]); w.w = cvt_pk_bf16(g[6], g[7]);
                f32x4 a0, a1;
                a0[0] = bflo(pq.x) * __builtin_amdgcn_rcpf(bflo(w.x)); a0[1] = bfhi(pq.x) * __builtin_amdgcn_rcpf(bfhi(w.x)); a0[2] = bflo(pq.y) * __builtin_amdgcn_rcpf(bflo(w.y)); a0[3] = bfhi(pq.y) * __builtin_amdgcn_rcpf(bfhi(w.y));
                a1[0] = bflo(pq.z) * __builtin_amdgcn_rcpf(bflo(w.z)); a1[1] = bfhi(pq.z) * __builtin_amdgcn_rcpf(bfhi(w.z)); a1[2] = bflo(pq.w) * __builtin_amdgcn_rcpf(bflo(w.w)); a1[3] = bfhi(pq.w) * __builtin_amdgcn_rcpf(bfhi(w.w));
                acc[ai][bj][m][0] = a0; acc[ai][bj][m][1] = a1;
                if (sl < NKR) cy.k[sl < NKR ? sl : 0] = w; else if (sl < NKR + NKL) gl[(sl - NKR) * 512] = w; else sg[sl * 64] = w; }
        } else {
            bf16* Ob = O + (size_t)row0 * DM + col0;
#pragma unroll
            for (int sl = NKR + NKL; sl < 16; ++sl) cin[sl - NKR] = sg[sl * 64];
#pragma unroll
            for (int sl = NKR; sl < NKR + NKL; ++sl) cin[sl - NKR] = gl[(sl - NKR) * 512];
#pragma unroll
            for (int sl = 0; sl < 16; ++sl) { const int ai = sl >> 3, bj = (sl >> 2) & 1, m = sl & 3; const f32x4 v0 = acc[ai][bj][m][0], v1 = acc[ai][bj][m][1];
                const u32x4 gq = (sl < NKR) ? cy.k[sl < NKR ? sl : 0] : cin[sl < NKR ? 0 : sl - NKR];
                u32x4 w; w.x = cvt_pk_bf16(v0[0] * bflo(gq.x), v0[1] * bfhi(gq.x)); w.y = cvt_pk_bf16(v0[2] * bflo(gq.y), v0[3] * bfhi(gq.y));
                w.z = cvt_pk_bf16(v1[0] * bflo(gq.z), v1[1] * bfhi(gq.z)); w.w = cvt_pk_bf16(v1[2] * bflo(gq.w), v1[3] * bfhi(gq.w));
                if (i == 3) *(u32x4*)(Ob + (ai * HALF + m * 16) * DM + bj * HALF) = w;
                else if (sl < NKR) cy.k[sl < NKR ? sl : 0] = w; else if (sl < NKR + NKL) gl[(sl - NKR) * 512] = w; else sg[sl * 64] = w; }
        }
    }
};
template <bool IN_BF, bool OUT_BF>
struct EpiOutT {
    static constexpr bool PERM = true; struct Carry {}; static __device__ __forceinline__ bool keeps_acc(int) { return false; } __device__ __forceinline__ void prefetch(const Unit&, int, int) const {}
    const float* xin; bf16* xb; bf16* xbo; const float* gate; bf16* xg; const float* gs; float* ssq; LAS float* tbl; int tid_;
    __device__ __forceinline__ void operator()(f32x4 (&acc)[2][2][4][2], const Unit& u, int wr, int wc, int fr, int fq, Carry&, int) const {
        const int b = u.pm >> 5; const float* gb = gate + (size_t)b * 3072;
        int tq = ((wr * 4 + wc) << 6) | (fq << 4) | fr; asm volatile("" : "+v"(fr), "+v"(fq), "+v"(tq));
        float ssl[2][4];
#pragma unroll
        for (int ai = 0; ai < 2; ++ai)
#pragma unroll
            for (int m = 0; m < 4; ++m) ssl[ai][m] = 0.f;
#pragma unroll
        for (int bj = 0; bj < 2; ++bj) {
            const int colb = u.pn * BM + bj * HALF + wc * 32 + 8 * fq; const f32x4 g0 = *(const f32x4*)(gb + colb), g1 = *(const f32x4*)(gb + colb + 4);
            f32x4 s0 = (f32x4){0.f, 0.f, 0.f, 0.f}, s1 = s0; if (gs) { s0 = *(const f32x4*)(gs + (size_t)b * DM + colb); s1 = *(const f32x4*)(gs + (size_t)b * DM + colb + 4); }
            u32x4 xw[2][4];
            if (IN_BF) {
#pragma unroll
                for (int ai = 0; ai < 2; ++ai)
#pragma unroll
                    for (int m = 0; m < 4; ++m) xw[ai][m] = *(const u32x4*)(xb + (size_t)(u.pm * BM + ai * HALF + wr * 64 + m * 16 + fr) * DM + colb);
            }
#pragma unroll
            for (int ai = 0; ai < 2; ++ai) {
                f32x4 xo[8];
                if (!IN_BF) {
#pragma unroll
                    for (int q = 0; q < 8; ++q) { const int n = q & 1, m = q >> 1; xo[q] = *(const f32x4*)(xin + (size_t)(u.pm * BM + ai * HALF + wr * 64 + m * 16 + fr) * DM + colb + 4 * n); }
                }
#pragma unroll
                for (int m = 0; m < 4; ++m) { const size_t off = (size_t)(u.pm * BM + ai * HALF + wr * 64 + m * 16 + fr) * DM + colb;
                    f32x4 oa, ob;
                    if (IN_BF) { const u32x4 w = xw[ai][m]; oa = (f32x4){bflo(w.x), bfhi(w.x), bflo(w.y), bfhi(w.y)}; ob = (f32x4){bflo(w.z), bfhi(w.z), bflo(w.w), bfhi(w.w)}; }
                    else { oa = xo[2 * m]; ob = xo[2 * m + 1]; }
                    const f32x4 xa = oa + g0 * acc[ai][bj][m][0], xb_ = ob + g1 * acc[ai][bj][m][1];
                    { u32x4 w; w.x = cvt_pk_bf16(xa.x, xa.y); w.y = cvt_pk_bf16(xa.z, xa.w); w.z = cvt_pk_bf16(xb_.x, xb_.y); w.w = cvt_pk_bf16(xb_.z, xb_.w); *(u32x4*)(xbo + off) = w; }
                    ssl[ai][m] += ((xa.x * xa.x + xa.y * xa.y) + (xa.z * xa.z + xa.w * xa.w)) + ((xb_.x * xb_.x + xb_.y * xb_.y) + (xb_.z * xb_.z + xb_.w * xb_.w));
                    if (gs) { const f32x4 ha = xa * s0, hb = xb_ * s1; u32x4 w; w.x = cvt_pk_bf16(ha.x, ha.y); w.y = cvt_pk_bf16(ha.z, ha.w); w.z = cvt_pk_bf16(hb.x, hb.y); w.w = cvt_pk_bf16(hb.z, hb.w); *(u32x4*)(xg + off) = w; } }
                if (!IN_BF) asm volatile("" ::: "memory");
            }
            asm volatile("" ::: "memory");
        }
#pragma unroll
        for (int ai = 0; ai < 2; ++ai)
#pragma unroll
            for (int m = 0; m < 4; ++m) { float v = ssl[ai][m]; v += xshfl<16>(v); v = xsum32_(v); if (fq == 0) tbl[(ai * HALF + wr * 64 + m * 16 + fr) * 4 + wc] = v; }
        asm volatile("s_waitcnt lgkmcnt(0)" ::: "memory"); __builtin_amdgcn_s_barrier(); asm volatile("" ::: "memory");
        { const int t = tq; if (t < 256) { const f32x4 q = *(const LAS f32x4*)(tbl + t * 4); ssq[(size_t)(u.pm * BM + t) * 4 + u.pn] = (q.x + q.y) + (q.z + q.w); } }
    }
};

struct EpiNull {
    static constexpr bool PERM = true; struct Carry {}; static __device__ __forceinline__ bool keeps_acc(int) { return false; } __device__ __forceinline__ void prefetch(const Unit&, int, int) const {} float* sink;
    __device__ __forceinline__ void operator()(f32x4 (&acc)[2][2][4][2], const Unit& u, int wr, int wc, int fr, int fq, Carry&, int) const {
        f32x4 s = (f32x4){0.f, 0.f, 0.f, 0.f};
#pragma unroll
        for (int a = 0; a < 2; ++a)
#pragma unroll
            for (int b = 0; b < 2; ++b)
#pragma unroll
                for (int m = 0; m < 4; ++m)
#pragma unroll
                    for (int n = 0; n < 2; ++n) s += acc[a][b][m][n];
        if ((s.x + s.y) + (s.z + s.w) == 1.2345e38f) sink[0] = s.x;
    }
};

template <class Epi, class Sched, bool ALIGN_EPI>
__device__ __forceinline__ void gemm_phase(LAS unsigned char* lds, const int lda, const int ldb, const Sched& S, const Epi& E, int tid) {
    asm volatile("" : "+v"(tid));
    const int wid = __builtin_amdgcn_readfirstlane(tid >> 6), lane = tid & 63, wr = wid >> 2, wc = wid & 3, fr = lane & 15, fq = lane >> 4;
    unsigned voffA[2], voffB[2];
#pragma unroll
    for (int i = 0; i < 2; ++i) { int R, C; stage_rc(tid * 16 + i * 8192, R, C); const int Rb = Epi::PERM ? ((R & ~31) + perm32(R & 31)) : R;
        voffA[i] = (unsigned)(R * lda + C) * 2u; voffB[i] = (unsigned)(Rb * ldb + C) * 2u; }
    const size_t kstep = (size_t)(BK * 2);
    const size_t hstepA = (size_t)HALF * lda * 2, hstepB = (size_t)HALF * ldb * 2;
    const unsigned ldsw = (unsigned)wid * 1024u;
    const int aoff = lds_byte(wr * 64 + fr, fq * 8), boff = lds_byte(wc * 32 + fr, fq * 8);
#define PG8_SA(b, h) (((b) * 2 + (h)) * HTB)
#define PG8_SB(b, h) ((4 + (b) * 2 + (h)) * HTB)
#define PG8_STAGE(bufoff, gbase, voff) do { _Pragma("unroll") for (int _i = 0; _i < 2; ++_i) { unsigned vo_ = (voff)[_i]; asm volatile("" : "+v"(vo_));     \
        __builtin_amdgcn_global_load_lds((const unsigned*)((const char*)(gbase) + vo_), (LAS unsigned*)(lds + (bufoff) + ldsw + _i * 8192), 16, 0, 0); } } while (0)
#define PG8_LDA(dst, b, h) do { _Pragma("unroll") for (int m = 0; m < 4; ++m) _Pragma("unroll") for (int k = 0; k < 2; ++k) dst[m][k] = *(const LAS bf16x8*)(lds + PG8_SA(b, h) + aoff + m * 2048 + k * 1024); } while (0)
#define PG8_LDB(dst, b, h) do { _Pragma("unroll") for (int n = 0; n < 2; ++n) _Pragma("unroll") for (int k = 0; k < 2; ++k) dst[n][k] = *(const LAS bf16x8*)(lds + PG8_SB(b, h) + boff + n * 2048 + k * 1024); } while (0)
#define PG8_MMA(ai, bj, At, Bt) do { __builtin_amdgcn_s_setprio(1); _Pragma("unroll") for (int m = 0; m < 4; ++m) _Pragma("unroll") for (int n = 0; n < 2; ++n) _Pragma("unroll") for (int k = 0; k < 2; ++k) \
        acc[ai][bj][m][n] = __builtin_amdgcn_mfma_f32_16x16x32_bf16(Bt[n][k], At[m][k], acc[ai][bj][m][n], 0, 0, 0); __builtin_amdgcn_s_setprio(0); } while (0)
#define PG8_WAIT_V(n) asm volatile("s_waitcnt vmcnt(" #n ")" ::: "memory")
#define PG8_WAIT_L(n) asm volatile("s_waitcnt lgkmcnt(" #n ")" ::: "memory")
#define PG8_BAR __builtin_amdgcn_s_barrier()
#define PG8_SCHED __builtin_amdgcn_sched_barrier(0)
    Unit cur, nxt; int ui = 0;
    if (!S.next(0, cur)) return;
    typename Epi::Carry carry;
    f32x4 acc[2][2][4][2];
#pragma unroll
    for (int a = 0; a < 2; ++a)
#pragma unroll
        for (int b = 0; b < 2; ++b)
#pragma unroll
            for (int m = 0; m < 4; ++m)
#pragma unroll
                for (int n = 0; n < 2; ++n) acc[a][b][m][n] = (f32x4){0.f, 0.f, 0.f, 0.f};
    bf16x8 At[4][2], B0[2][2], B1[2][2];
    const char* cA = cur.A; const char* cB = cur.B;
    PG8_STAGE(PG8_SB(0, 0), cB, voffB); PG8_STAGE(PG8_SB(0, 1), cB + hstepB, voffB); PG8_STAGE(PG8_SA(0, 0), cA, voffA); PG8_STAGE(PG8_SA(0, 1), cA + hstepA, voffA);
    if (wr == 1) PG8_BAR;
    PG8_WAIT_V(2); PG8_BAR;
    PG8_STAGE(PG8_SB(1, 0), cB + kstep, voffB); PG8_STAGE(PG8_SA(1, 0), cA + kstep, voffA); PG8_STAGE(PG8_SB(1, 1), cB + hstepB + kstep, voffB);
    PG8_WAIT_V(6); PG8_BAR;
    for (;;) {
        const bool has_next = S.next(ui + 1, nxt);
        const char* nA = has_next ? nxt.A : cA; const char* nB = has_next ? nxt.B : cB;
        const int nt = cur.nt;
        E.prefetch(cur, wid, ui);
        for (int t = 0; t < nt; t += 2) {
            const bool last = (t == nt - 2);
            const char* a1 = cA + (size_t)(t + 1) * kstep;
            const char* a2 = last ? nA : cA + (size_t)(t + 2) * kstep; const char* b2 = last ? nB : cB + (size_t)(t + 2) * kstep;
            const char* a3 = a2 + kstep; const char* b3 = b2 + kstep;
            PG8_LDB(B0, 0, 0); PG8_LDB(B1, 0, 1); PG8_SCHED; PG8_LDA(At, 0, 0); PG8_STAGE(PG8_SA(1, 1), a1 + hstepA, voffA);
            PG8_WAIT_V(8); PG8_WAIT_L(0); PG8_BAR; PG8_MMA(0, 0, At, B0); PG8_MMA(0, 1, At, B1); PG8_BAR; PG8_SCHED;
            PG8_LDA(At, 0, 1); PG8_STAGE(PG8_SB(0, 0), b2, voffB); PG8_STAGE(PG8_SB(0, 1), b2 + hstepB, voffB); PG8_STAGE(PG8_SA(0, 0), a2, voffA);
            PG8_WAIT_V(8); PG8_WAIT_L(0); PG8_BAR; PG8_MMA(1, 0, At, B0); PG8_MMA(1, 1, At, B1); PG8_BAR; PG8_SCHED;
            PG8_LDB(B0, 1, 0); PG8_LDB(B1, 1, 1); PG8_SCHED; PG8_LDA(At, 1, 0); PG8_STAGE(PG8_SA(0, 1), a2 + hstepA, voffA);
            PG8_WAIT_V(8); PG8_WAIT_L(0); PG8_BAR; PG8_MMA(0, 0, At, B0); PG8_MMA(0, 1, At, B1); PG8_BAR; PG8_SCHED;
            PG8_LDA(At, 1, 1); PG8_STAGE(PG8_SB(1, 0), b3, voffB); PG8_STAGE(PG8_SB(1, 1), b3 + hstepB, voffB); PG8_STAGE(PG8_SA(1, 0), a3, voffA);
            PG8_WAIT_V(8); PG8_WAIT_L(0); PG8_BAR; PG8_MMA(1, 0, At, B0); PG8_MMA(1, 1, At, B1); PG8_BAR; PG8_SCHED;
        }
        if constexpr (ALIGN_EPI) { if (wr == 0) PG8_BAR; }
        { const int ln = lane_id_now(); E(acc, cur, wr, wc, ln & 15, ln >> 4, carry, ui); }
        if (!has_next) break;
        if (!Epi::keeps_acc(cur.kind)) {
#pragma unroll
        for (int a = 0; a < 2; ++a)
#pragma unroll
            for (int b = 0; b < 2; ++b)
#pragma unroll
                for (int m = 0; m < 4; ++m)
#pragma unroll
                    for (int n = 0; n < 2; ++n) acc[a][b][m][n] = (f32x4){0.f, 0.f, 0.f, 0.f};
        }
        cur = nxt; cA = nA; cB = nB; ++ui;
        if constexpr (ALIGN_EPI) { if (wr == 1) PG8_BAR; }
    }
    PG8_WAIT_V(0);
    if constexpr (!ALIGN_EPI) { if (wr == 0) PG8_BAR; }
    PG8_BAR;
#undef PG8_SA
#undef PG8_SB
#undef PG8_STAGE
#undef PG8_LDA
#undef PG8_LDB
#undef PG8_MMA
#undef PG8_WAIT_V
#undef PG8_WAIT_L
#undef PG8_BAR
#undef PG8_SCHED
}
}

struct Args {
    const float* x; const float* c; const float* w_ada; const float* b_ada; const float* norm_g; const float* w_in; const float* cmp_pos; const float* cmp_w1; const float* cmp_w2;
    const float* sink; const float* w_merge; const float* w_br; const float* w_out; const float* final_g;
    float* out; unsigned char* ws; int ph_lo, ph_hi, li, pad;
};

__device__ __forceinline__ int win_src_col(int n) { return n < 640 ? n : (n < 3712 ? n + 12 : (n < 3724 ? n - 3072 : -1)); }
template <bool WINMAP>
__device__ __forceinline__ void transpose_item(const float* W, int spitch, bf16* WT, int dpitch, int dkoff, LAS float* scr, int kb, int nb, int lane) {
    const int k0 = 64 * kb, n0 = 32 * nb;
    int sc = n0 + (lane & 31); if (WINMAP) sc = win_src_col(sc);
    float wv[32];
#pragma unroll
    for (int i = 0; i < 32; ++i) { const int kk = 2 * i + (lane >> 5); wv[i] = sc >= 0 ? W[(size_t)(k0 + kk) * spitch + sc] : 0.f; }
#pragma unroll
    for (int i = 0; i < 32; ++i) { const int kk = 2 * i + (lane >> 5); scr[kk * 33 + (lane & 31)] = wv[i]; }
    LDS_WAIT(); asm volatile("" ::: "memory");
    const int c = lane & 7;
#pragma unroll
    for (int j = 0; j < 4; ++j) { const int n = (lane >> 3) + 8 * j; const LAS float* s = scr + (8 * c) * 33 + n;
        u32x4 o; o.x = pk2(s[0 * 33], s[1 * 33]); o.y = pk2(s[2 * 33], s[3 * 33]); o.z = pk2(s[4 * 33], s[5 * 33]); o.w = pk2(s[6 * 33], s[7 * 33]);
        *(u32x4*)(WT + (size_t)(n0 + n) * dpitch + dkoff + k0 + 8 * c) = o; }
    LDS_WAIT(); asm volatile("" ::: "memory");
}

namespace fa {
typedef float f32x16 __attribute__((ext_vector_type(16)));
typedef short s16x4 __attribute__((ext_vector_type(4)));
typedef short v4i16_t __attribute__((ext_vector_type(4)));
constexpr int SLOT = 16384, L_STG = 65536, L_SEL = 132096, L_UNI = L_SEL + 1024, L_WSF = L_UNI + 64, L_FLG = L_WSF + 2048;
constexpr float LOG2E = 1.4426950408889634f;
__device__ __forceinline__ int crow(int r, int hi) { return (r & 3) + 8 * (r >> 2) + 4 * hi; }
__device__ __forceinline__ float xmax32(float v) { auto rr = __builtin_amdgcn_permlane32_swap(__float_as_uint(v), __float_as_uint(v), false, false); return fmaxf(__uint_as_float(rr[0]), __uint_as_float(rr[1])); }
__device__ __forceinline__ float xsum32(float v) { auto rr = __builtin_amdgcn_permlane32_swap(__float_as_uint(v), __float_as_uint(v), false, false); return __uint_as_float(rr[0]) + __uint_as_float(rr[1]); }
__device__ __forceinline__ void dma_tile(const bf16* k0, const bf16* v0, size_t pitch, LAS unsigned char* slot, int wid, int lane) {
    __builtin_amdgcn_global_load_lds((const unsigned*)(k0 + (size_t)lane * pitch + wid * 8), (LAS unsigned*)(slot + wid * 1024), 16, 0, 0);
    __builtin_amdgcn_global_load_lds((const unsigned*)(v0 + (size_t)(16 * (wid & 3) + (lane >> 2)) * pitch + (wid >> 2) * 32 + (lane & 3) * 8), (LAS unsigned*)(slot + 8192 + wid * 1024), 16, 0, 0);
}
#define FA_WAIT(n) asm volatile("s_waitcnt vmcnt(" #n ") lgkmcnt(0)" ::: "memory")
#define FA_BAR() do { __builtin_amdgcn_s_barrier(); asm volatile("" ::: "memory"); } while (0)
template <class Next, class Issue, class Compute, class Prelude>
__device__ __forceinline__ void tile_stream(int first, Next next, Issue issue, Compute compute, Prelude prelude);
template <class Next, class Issue, class Compute>
__device__ __forceinline__ void tile_stream(int first, Next next, Issue issue, Compute compute) { tile_stream(first, next, issue, compute, []() {}); }
template <class Next, class Issue, class Compute, class Prelude>
__device__ __forceinline__ void tile_stream(int first, Next next, Issue issue, Compute compute, Prelude prelude) {
    int t0 = first, t1 = t0 >= 0 ? next(t0) : -1, t2 = t1 >= 0 ? next(t1) : -1, t3 = t2 >= 0 ? next(t2) : -1, slot = 0;
    if (t0 >= 0) issue(t0, 0);
    if (t1 >= 0) issue(t1, 1);
    if (t2 >= 0) issue(t2, 2);
    prelude();
    while (t0 >= 0) {
        if (t2 >= 0) FA_WAIT(4); else if (t1 >= 0) FA_WAIT(2); else FA_WAIT(0);
        FA_BAR();
        if (t3 >= 0) issue(t3, (slot + 3) & 3);
        compute(t0, slot);
        t0 = t1; t1 = t2; t2 = t3; t3 = t2 >= 0 ? next(t2) : -1; slot = (slot + 1) & 3;
    }
    FA_BAR();
}
__device__ __forceinline__ void qkt(f32x16& p0, f32x16& p1, const LAS unsigned char* kt, const bf16x8 (&qr)[4], int r32, int hi) {
    const LAS unsigned char* kb = kt + hi * 1024 + r32 * 16;
    p0 = (f32x16){0.f, 0.f, 0.f, 0.f, 0.f, 0.f, 0.f, 0.f, 0.f, 0.f, 0.f, 0.f, 0.f, 0.f, 0.f, 0.f}; p1 = p0;
#pragma unroll
    for (int d0 = 0; d0 < 4; ++d0) { const bf16x8 b0 = *(const LAS bf16x8*)(kb + d0 * 2048), b1 = *(const LAS bf16x8*)(kb + d0 * 2048 + 512);
        p0 = __builtin_amdgcn_mfma_f32_32x32x16_bf16(b0, qr[d0], p0, 0, 0, 0); p1 = __builtin_amdgcn_mfma_f32_32x32x16_bf16(b1, qr[d0], p1, 0, 0, 0); }
}
__device__ __forceinline__ s16x4 vtr(const LAS unsigned char* p) { return __builtin_bit_cast(s16x4, __builtin_amdgcn_ds_read_tr16_b64_v4i16((LAS v4i16_t*)p)); }
__device__ __forceinline__ void pv(f32x16 (&o)[2], const LAS unsigned char* vt, const u32x4 (&pw)[4], int lane) {
    const LAS unsigned char* vp = vt + ((lane >> 4) & 1) * 32 + (lane & 3) * 8 + (4 * (lane >> 5) + ((lane & 15) >> 2)) * 64;
#pragma unroll
    for (int d0 = 0; d0 < 2; ++d0)
#pragma unroll
        for (int ks = 0; ks < 4; ++ks) { const s16x4 lo = vtr(vp + d0 * 4096 + ks * 1024), hi4 = vtr(vp + d0 * 4096 + ks * 1024 + 512);
            const bf16x8 vf = (bf16x8){lo[0], lo[1], lo[2], lo[3], hi4[0], hi4[1], hi4[2], hi4[3]};
            o[d0] = __builtin_amdgcn_mfma_f32_32x32x16_bf16(__builtin_bit_cast(bf16x8, pw[ks]), vf, o[d0], 0, 0, 0); }
}
__device__ __forceinline__ void pack_p(u32x4 (&pw)[4], const f32x16& p0, const f32x16& p1) {
    pw[0] = (u32x4){cvt_pk_bf16(p0[0], p0[1]), cvt_pk_bf16(p0[2], p0[3]), cvt_pk_bf16(p0[4], p0[5]), cvt_pk_bf16(p0[6], p0[7])};
    pw[1] = (u32x4){cvt_pk_bf16(p0[8], p0[9]), cvt_pk_bf16(p0[10], p0[11]), cvt_pk_bf16(p0[12], p0[13]), cvt_pk_bf16(p0[14], p0[15])};
    pw[2] = (u32x4){cvt_pk_bf16(p1[0], p1[1]), cvt_pk_bf16(p1[2], p1[3]), cvt_pk_bf16(p1[4], p1[5]), cvt_pk_bf16(p1[6], p1[7])};
    pw[3] = (u32x4){cvt_pk_bf16(p1[8], p1[9]), cvt_pk_bf16(p1[10], p1[11]), cvt_pk_bf16(p1[12], p1[13]), cvt_pk_bf16(p1[14], p1[15])};
}
__device__ __forceinline__ void scale_rows(f32x16 (&o)[2], float f, LAS float* wsf, int r32, int hi) {
    if (hi == 0) wsf[r32] = f;
#pragma unroll
    for (int r = 0; r < 16; ++r) { const float fr = wsf[crow(r, hi)]; o[0][r] *= fr; o[1][r] *= fr; }
}
__device__ __forceinline__ void stage_o(const f32x16 (&o)[2], LAS float* stg, int r32, int hi) {
#pragma unroll
    for (int r = 0; r < 16; ++r) { const int orow = crow(r, hi); stg[orow * 64 + r32] = o[0][r]; stg[orow * 64 + 32 + r32] = o[1][r]; }
}
__device__ __forceinline__ void load_z(u32x4 (&z)[4], const bf16* P, size_t m0, int zcol, int h, int lane) {
#pragma unroll
    for (int i = 0; i < 4; ++i) z[i] = *(const u32x4*)(P + (m0 + i * 8 + (lane >> 3)) * PW + zcol + h * 64 + (lane & 7) * 8);
}
__device__ __forceinline__ void emit_y(const LAS float* stg, const u32x4 (&zz)[4], bf16* Y, size_t m0, int ycol, int h, int lane) {
#pragma unroll
    for (int i = 0; i < 4; ++i) { const int row = i * 8 + (lane >> 3), ch = lane & 7;
        const f32x4 a = *(const LAS f32x4*)(stg + row * 64 + ch * 8), c = *(const LAS f32x4*)(stg + row * 64 + ch * 8 + 4);
        const u32x4 z = zz[i];
        u32x4 w; w.x = cvt_pk_bf16(a.x * siluf_(bflo(z.x)), a.y * siluf_(bfhi(z.x))); w.y = cvt_pk_bf16(a.z * siluf_(bflo(z.y)), a.w * siluf_(bfhi(z.y)));
        w.z = cvt_pk_bf16(c.x * siluf_(bflo(z.z)), c.y * siluf_(bfhi(z.z))); w.w = cvt_pk_bf16(c.z * siluf_(bflo(z.w)), c.w * siluf_(bfhi(z.w)));
        *(u32x4*)(Y + (m0 + row) * DM + ycol + h * 64 + ch * 8) = w; }
}
__device__ __forceinline__ void softmax_step(f32x16& p0, f32x16& p1, float& m, float& l, f32x16 (&o)[2], LAS float* wsf, int r32, int hi) {
    float rm = fmaxf(p0[0], p1[0]);
#pragma unroll
    for (int r = 1; r < 16; ++r) rm = fmaxf(rm, fmaxf(p0[r], p1[r]));
    rm = xmax32(rm);
    const float mn = fmaxf(m, rm), f = __builtin_amdgcn_exp2f(m - mn); m = mn;
    float rs = 0.f;
#pragma unroll
    for (int r = 0; r < 16; ++r) { p0[r] = (p0[r] > -1e29f) ? __builtin_amdgcn_exp2f(p0[r] - mn) : 0.f; p1[r] = (p1[r] > -1e29f) ? __builtin_amdgcn_exp2f(p1[r] - mn) : 0.f; rs += p0[r] + p1[r]; }
    l = l * f + xsum32(rs);
    if (__any(f != 1.f)) scale_rows(o, f, wsf, r32, hi);
}

constexpr int L_DUMMY = L_FLG + 1024;
enum { K_NONE = 0, K_SWA = 1, K_STICK = 2, K_NSA = 3, K_RET = 4, K_NSA_TOUCH = 5 };
struct NextUnit { int kind, unit; bool with_r; };
struct PreCtx { const bf16* P; const bf16* KCB; const bf16* VCB; const float* R; };
__device__ __forceinline__ void touch_line(const void* p, LAS unsigned char* lds, int wid) { __builtin_amdgcn_global_load_lds((const unsigned*)p, (LAS unsigned*)(lds + L_DUMMY + wid * 256), 4, 0, 0); }
__device__ __forceinline__ void swa_first(const bf16* P, int unit, LAS unsigned char* lds, int wid, int lane, bool touch) {
    const int b = unit >> 7, kvh = (unit >> 6) & 1, pos0 = (unit & 63) * 128; const bf16* Pb = P + (size_t)b * SEQ * PW;
    const int jlo = (pos0 >= 127 ? pos0 - 127 : 0) >> 6, jhi = (pos0 + 127) >> 6;
    const bf16* kb = Pb + B_K + kvh * 64; const bf16* vb = Pb + B_V + kvh * 64;
    for (int j = jlo; j <= jhi; ++j) dma_tile(kb + (size_t)(64 * j) * PW, vb + (size_t)(64 * j) * PW, PW, lds + (j - jlo) * SLOT, wid, lane);
    if (touch) { const int idx = wid * 64 + lane, row = idx >> 2, li = idx & 3;
        touch_line((const char*)(Pb + (size_t)(pos0 + row) * PW) + ((li < 2 ? B_Q : B_Z) * 2 + kvh * 256 + (li & 1) * 128), lds, wid); }
}
__device__ __forceinline__ void stick_first(const bf16* P, int unit, LAS unsigned char* lds, int wid, int lane, bool touch) {
    const int b = unit >> 7, h0 = 2 * ((unit >> 6) & 1), pos0 = (unit & 63) * 128, jtop = (pos0 + 126) >> 6; const bf16* Pb = P + (size_t)b * SEQ * PW;
    const bf16* kb = Pb + C_K + h0 * 64; const bf16* vb = Pb + C_V + h0 * 64;
    dma_tile(kb + (size_t)(64 * jtop) * PW, vb + (size_t)(64 * jtop) * PW, PW, lds, wid, lane);
    dma_tile(kb + 64 + (size_t)(64 * jtop) * PW, vb + 64 + (size_t)(64 * jtop) * PW, PW, lds + SLOT, wid, lane);
    if (touch) { const int idx = wid * 64 + lane, row = idx >> 2, li = idx & 3;
        touch_line((const char*)(Pb + (size_t)(pos0 + row) * PW) + ((li < 2 ? C_Q : C_Z) * 2 + h0 * 128 + (li & 1) * 128), lds, wid); }
}
__device__ __forceinline__ void nsa_first(const bf16* P, const bf16* KCB, const bf16* VCB, int unit, LAS unsigned char* lds, int wid, int lane, bool touch, bool tiles) {
    const int b = unit >> 7, pos0 = ((b & 2) ? 127 - (unit & 127) : (unit & 127)) * 64, ncvmax = (pos0 >> 5) + 2, ntile = tiles ? (ncvmax + 63) >> 6 : 0;
    for (int tl = 0; tl < ntile; ++tl) {
        __builtin_amdgcn_global_load_lds((const unsigned*)(KCB + ((size_t)b * 256 + 64 * tl + lane) * 64 + wid * 8), (LAS unsigned*)(lds + tl * 8192 + wid * 1024), 16, 0, 0);
        __builtin_amdgcn_global_load_lds((const unsigned*)(VCB + ((size_t)b * 256 + 64 * tl + 16 * (wid & 3) + (lane >> 2)) * 64 + (wid >> 2) * 32 + (lane & 3) * 8), (LAS unsigned*)(lds + 32768 + tl * 8192 + wid * 1024), 16, 0, 0); }
    if (touch) { const bf16* Pb = P + (size_t)b * SEQ * PW; const int idx = wid * 64 + lane, row = idx >> 3, li = idx & 7;
        touch_line((const char*)(Pb + (size_t)(pos0 + row) * PW) + ((li < 4 ? A_Q : A_Z) * 2 + (li & 3) * 128), lds, wid);
        if (wid == 0) touch_line((const char*)(Pb + (size_t)(pos0 + lane) * PW) + A_G * 2, lds, wid); }
}
__device__ __forceinline__ void ret_first(const bf16* P, const float* R, int unit, LAS unsigned char* lds, int wid, int lane, bool touch, bool with_r) {
    const int b = unit >> 7, h = (unit >> 5) & 3, pos0 = (unit & 31) * 256, j0 = pos0 >> 6; const bf16* Pb = P + (size_t)b * SEQ * PW;
    const bf16* kb = Pb + D_K + h * 64; const bf16* vb = Pb + D_V + h * 64;
#pragma unroll
    for (int tt = 0; tt < 4; ++tt) dma_tile(kb + (size_t)(64 * (j0 + tt)) * PW, vb + (size_t)(64 * (j0 + tt)) * PW, PW, lds + (2 * (tt & 1) + (tt >> 1)) * SLOT, wid, lane);
    if (touch) { const int idx = wid * 64 + lane, row = idx >> 1, li = idx & 1;
        touch_line((const char*)(Pb + (size_t)(pos0 + row) * PW) + ((li ? D_Z : D_Q) * 2 + h * 128), lds, wid);
        if (with_r && wid < 4) { const int n = (pos0 >> 7) + (idx >> 7); touch_line((const char*)(R + ((((size_t)b * 64 + n) * 4 + h) * 64) * 64) + (idx & 127) * 128, lds, wid); } }
}
__device__ __forceinline__ void issue_first(const NextUnit& nx, const PreCtx& pc, LAS unsigned char* lds, int wid, int lane) {
    if (nx.kind == K_SWA) swa_first(pc.P, nx.unit, lds, wid, lane, true);
    else if (nx.kind == K_STICK) stick_first(pc.P, nx.unit, lds, wid, lane, true);
    else if (nx.kind == K_NSA) nsa_first(pc.P, pc.KCB, pc.VCB, nx.unit, lds, wid, lane, true, true);
    else if (nx.kind == K_NSA_TOUCH) nsa_first(pc.P, pc.KCB, pc.VCB, nx.unit, lds, wid, lane, true, false);
    else if (nx.kind == K_RET) ret_first(pc.P, pc.R, nx.unit, lds, wid, lane, true, nx.with_r);
}
__device__ __forceinline__ void swa_unit(const bf16* P, const float* sink4, bf16* Y, int unit, LAS unsigned char* lds, int tid, bool pre, const NextUnit& nx, const PreCtx& pc) {
    asm volatile("" : "+v"(tid));
    const int lane = tid & 63, wid = __builtin_amdgcn_readfirstlane(tid >> 6), r32 = lane & 31, hi = lane >> 5;
    const int b = unit >> 7, kvh = (unit >> 6) & 1, pos0 = (unit & 63) * 128, h = 2 * kvh + (wid & 1), tw0 = pos0 + 32 * (wid >> 1), t = tw0 + r32;
    const bf16* Pb = P + (size_t)b * SEQ * PW;
    bf16x8 qr[4];
#pragma unroll
    for (int d0 = 0; d0 < 4; ++d0) qr[d0] = *(const bf16x8*)(Pb + (size_t)t * PW + B_Q + h * 64 + d0 * 16 + hi * 8);
    const float slope2 = exp2f(-2.f * (float)(h + 1)) * LOG2E, scale2 = 0.125f * LOG2E;
    u32x4 zz[4]; load_z(zz, P, (size_t)b * SEQ + tw0, B_Z, h, lane);
    float m = sink4[h] * LOG2E, l = 1.f; f32x16 o[2];
#pragma unroll
    for (int r = 0; r < 16; ++r) { o[0][r] = 0.f; o[1][r] = 0.f; }
    LAS float* wsf = (LAS float*)(lds + L_WSF) + wid * 64; LAS float* stg = (LAS float*)(lds + L_STG) + wid * 2048;
    const int jlo = (pos0 >= 127 ? pos0 - 127 : 0) >> 6, jhi = (pos0 + 127) >> 6;
    const bf16* kb = Pb + B_K + kvh * 64; const bf16* vb = Pb + B_V + kvh * 64;
    if (!pre) for (int j = jlo; j <= jhi; ++j) dma_tile(kb + (size_t)(64 * j) * PW, vb + (size_t)(64 * j) * PW, PW, lds + (j - jlo) * SLOT, wid, lane);
    FA_WAIT(0); FA_BAR();
    for (int j = jlo; j <= jhi; ++j) {
        if (64 * j + 63 >= tw0 - 127 && 64 * j <= tw0 + 31) {
            const LAS unsigned char* kt = lds + (j - jlo) * SLOT;
            f32x16 p0, p1; qkt(p0, p1, kt, qr, r32, hi);
            const int d0 = t - (64 * j + 4 * hi);
#pragma unroll
            for (int r = 0; r < 16; ++r) { const int d = d0 - ((r & 3) + 8 * (r >> 2)), e = d - 32;
                p0[r] = (d >= 0 && d < 128) ? p0[r] * scale2 - slope2 * (float)d : -1e30f; p1[r] = (e >= 0 && e < 128) ? p1[r] * scale2 - slope2 * (float)e : -1e30f; }
            softmax_step(p0, p1, m, l, o, wsf, r32, hi);
            u32x4 pw[4]; pack_p(pw, p0, p1); pv(o, kt + 8192, pw, lane);
        }
    }
    FA_BAR();
    issue_first(nx, pc, lds, wid, lane);
    scale_rows(o, 1.f / l, wsf, r32, hi);
    stage_o(o, stg, r32, hi);
    emit_y(stg, zz, Y, (size_t)b * SEQ + tw0, 256, h, lane);
}
__device__ __forceinline__ void stick_unit(const bf16* P, bf16* Y, int unit, LAS unsigned char* lds, int tid, bool pre, const NextUnit& nx, const PreCtx& pc) {
    asm volatile("" : "+v"(tid));
    const int lane = tid & 63, wid = __builtin_amdgcn_readfirstlane(tid >> 6), r32 = lane & 31, hi = lane >> 5;
    const int b = unit >> 7, hs = wid >> 2, h = 2 * ((unit >> 6) & 1) + hs, pos0 = (unit & 63) * 128, tw0 = pos0 + 32 * (wid & 3), t = tw0 + r32;
    const bf16* Pb = P + (size_t)b * SEQ * PW;
    bf16x8 qr[4];
#pragma unroll
    for (int d0 = 0; d0 < 4; ++d0) qr[d0] = *(const bf16x8*)(Pb + (size_t)t * PW + C_Q + h * 64 + d0 * 16 + hi * 8);
    u32x4 zz[4]; load_z(zz, P, (size_t)b * SEQ + tw0, C_Z, h, lane);
    float carry = 1.f; f32x16 o[2];
#pragma unroll
    for (int r = 0; r < 16; ++r) { o[0][r] = 0.f; o[1][r] = 0.f; }
    LAS float* stg = (LAS float*)(lds + L_STG) + wid * 2048; volatile LAS unsigned* flags = (volatile LAS unsigned*)(lds + L_FLG);
    const int jtop = (pos0 + 126) >> 6, h0 = 2 * ((unit >> 6) & 1);
    if (lane == 0) { flags[wid] = 0u; flags[8 + wid] = 0u; }
    const bf16* kb = Pb + C_K + h0 * 64; const bf16* vb = Pb + C_V + h0 * 64;
#define STK_ISSUE(j, pr) do { dma_tile(kb + (size_t)(64 * (j)) * PW, vb + (size_t)(64 * (j)) * PW, PW, lds + (2 * (pr)) * SLOT, wid, lane); \
                              dma_tile(kb + 64 + (size_t)(64 * (j)) * PW, vb + 64 + (size_t)(64 * (j)) * PW, PW, lds + (2 * (pr) + 1) * SLOT, wid, lane); } while (0)
    int t0 = jtop, it = 0; bool done = false;
    if (!pre) STK_ISSUE(jtop, 0);
    while (t0 >= 0) {
        FA_WAIT(0);
        FA_BAR();
        { unsigned nd = 0; const volatile LAS unsigned* fl = flags + (it & 1) * 8;
#pragma unroll
          for (int w = 0; w < 8; ++w) nd += fl[w];
          if (__builtin_amdgcn_readfirstlane(nd) == 8u) break; }
        if (t0 >= 1) STK_ISSUE(t0 - 1, (it + 1) & 1);
        const int j = t0; const LAS unsigned char* kt = lds + (2 * (it & 1) + hs) * SLOT;
        if (!done && 64 * j <= tw0 + 30) {
            f32x16 p0, p1, s0, s1; qkt(p0, p1, kt, qr, r32, hi);
            const int d0 = t - (64 * j + 4 * hi);
            constexpr float NC = -0.125f * LOG2E;
            if (64 * j + 63 < tw0) {
#pragma unroll
                for (int r = 0; r < 16; ++r) { const float e0 = __builtin_amdgcn_exp2f(fminf(p0[r] * NC, 115.f)), e1 = __builtin_amdgcn_exp2f(fminf(p1[r] * NC, 115.f));
                    const float b0 = __builtin_amdgcn_rcpf(1.f + e0), b1 = __builtin_amdgcn_rcpf(1.f + e1);
                    p0[r] = b0; p1[r] = b1; s0[r] = e0 * b0; s1[r] = e1 * b1; }
            } else {
#pragma unroll
            for (int r = 0; r < 16; ++r) { const int d = d0 - ((r & 3) + 8 * (r >> 2)), e = d - 32;
                const float e0 = __builtin_amdgcn_exp2f(fminf(p0[r] * NC, 115.f)), e1 = __builtin_amdgcn_exp2f(fminf(p1[r] * NC, 115.f));
                const float b0 = __builtin_amdgcn_rcpf(1.f + e0), b1 = __builtin_amdgcn_rcpf(1.f + e1);
                p0[r] = (d >= 1) ? b0 : 0.f; p1[r] = (e >= 1) ? b1 : 0.f; s0[r] = (d >= 1) ? e0 * b0 : 1.f; s1[r] = (e >= 1) ? e1 * b1 : 1.f; }
            }
            float T[8], PT[8], after[8];
#pragma unroll
            for (int k = 0; k < 4; ++k) { T[k] = (s0[4 * k] * s0[4 * k + 1]) * (s0[4 * k + 2] * s0[4 * k + 3]); T[4 + k] = (s1[4 * k] * s1[4 * k + 1]) * (s1[4 * k + 2] * s1[4 * k + 3]); }
#pragma unroll
            for (int k = 0; k < 8; ++k) { auto rr = __builtin_amdgcn_permlane32_swap(__float_as_uint(T[k]), __float_as_uint(T[k]), false, false); PT[k] = __uint_as_float(hi ? rr[0] : rr[1]); }
            float aT = 1.f, aP = 1.f;
#pragma unroll
            for (int k = 7; k >= 0; --k) { after[k] = aT * (hi ? aP : aP * PT[k]); aT *= T[k]; aP *= PT[k]; }
#pragma unroll
            for (int k = 0; k < 4; ++k) { float run0 = after[k] * carry, run1 = after[4 + k] * carry;
#pragma unroll
                for (int e = 3; e >= 0; --e) { const int r = 4 * k + e;
                    const float w0 = p0[r] * run0, w1 = p1[r] * run1;
                    run0 *= s0[r]; run1 *= s1[r]; p0[r] = w0; p1[r] = w1; } }
            carry *= aT * aP;
            u32x4 pw[4]; pack_p(pw, p0, p1); pv(o, kt + 8192, pw, lane);
            done = __all(carry == 0.f);
        }
        if (lane == 0) flags[((it + 1) & 1) * 8 + wid] = (done || j == 0) ? 1u : 0u;
        --t0; ++it;
    }
#undef STK_ISSUE
    FA_WAIT(0); FA_BAR();
    issue_first(nx, pc, lds, wid, lane);
    stage_o(o, stg, r32, hi);
    emit_y(stg, zz, Y, (size_t)b * SEQ + tw0, 512, h, lane);
}
__device__ __forceinline__ void ret_unit(const bf16* P, const float* R, bf16* Y, int unit, LAS unsigned char* lds, int tid, bool pre, const NextUnit& nx, const PreCtx& pc) {
    asm volatile("" : "+v"(tid));
    const int lane = tid & 63, wid = __builtin_amdgcn_readfirstlane(tid >> 6), r32 = lane & 31, hi = lane >> 5;
    const int b = unit >> 7, h = (unit >> 5) & 3, pos0 = (unit & 31) * 256, ch = wid >> 2, n = (pos0 >> 7) + ch, i0 = 32 * (wid & 3), i = i0 + r32, tw0 = pos0 + 128 * ch + i0;
    const bf16* Pb = P + (size_t)b * SEQ * PW;
    bf16x8 qr[4];
#pragma unroll
    for (int d0 = 0; d0 < 4; ++d0) qr[d0] = *(const bf16x8*)(Pb + (size_t)(tw0 + r32) * PW + D_Q + h * 64 + d0 * 16 + hi * 8);
    const float lg2 = __builtin_amdgcn_logf(1.f - exp2f(-5.f - (float)h));
    u32x4 zz[4]; load_z(zz, P, (size_t)b * SEQ + tw0, D_Z, h, lane);
    float cG[16]; const float g32 = __builtin_amdgcn_exp2f(lg2 * -32.f);
#pragma unroll
    for (int r = 0; r < 16; ++r) cG[r] = __builtin_amdgcn_exp2f(-lg2 * (float)((r & 3) + 8 * (r >> 2)));
    f32x16 o[2], o2[2];
#pragma unroll
    for (int r = 0; r < 16; ++r) { o[0][r] = 0.f; o[1][r] = 0.f; o2[0][r] = 0.f; o2[1][r] = 0.f; }
    LAS float* wsf = (LAS float*)(lds + L_WSF) + wid * 64; LAS float* stg = (LAS float*)(lds + L_STG) + wid * 2048;
    const int j0 = pos0 >> 6;
    const bf16* kb = Pb + D_K + h * 64; const bf16* vb = Pb + D_V + h * 64;
    if (!pre) {
#pragma unroll
    for (int tt = 0; tt < 4; ++tt) dma_tile(kb + (size_t)(64 * (j0 + tt)) * PW, vb + (size_t)(64 * (j0 + tt)) * PW, PW, lds + (2 * (tt & 1) + (tt >> 1)) * SLOT, wid, lane);
    }
    { const float* Rn = R + ((((size_t)b * 64 + n) * 4 + h) * 64) * 64;
#pragma unroll
      for (int d0 = 0; d0 < 4; ++d0)
#pragma unroll
          for (int eh = 0; eh < 2; ++eh) { const float* rp = Rn + (size_t)(16 * d0 + 8 * hi) * 64 + 32 * eh + r32;
              u32x4 w; w.x = cvt_pk_bf16(rp[0], rp[64]); w.y = cvt_pk_bf16(rp[128], rp[192]); w.z = cvt_pk_bf16(rp[256], rp[320]); w.w = cvt_pk_bf16(rp[384], rp[448]);
              o2[eh] = __builtin_amdgcn_mfma_f32_32x32x16_bf16(qr[d0], __builtin_bit_cast(bf16x8, w), o2[eh], 0, 0, 0); } }
    FA_WAIT(0); FA_BAR();
#pragma unroll
    for (int tl = 0; tl < 2; ++tl) {
        if (64 * tl <= i0 + 31) {
            const LAS unsigned char* kt = lds + (2 * tl + ch) * SLOT;
            f32x16 p0, p1; qkt(p0, p1, kt, qr, r32, hi);
            const int d0 = i - (64 * tl + 4 * hi);
            const float rf0 = 0.125f * __builtin_amdgcn_exp2f(lg2 * (float)d0), rf1 = rf0 * g32;
            if (64 * tl + 63 <= i0) {
#pragma unroll
                for (int r = 0; r < 16; ++r) { p0[r] = p0[r] * rf0 * cG[r]; p1[r] = p1[r] * rf1 * cG[r]; }
            } else {
#pragma unroll
                for (int r = 0; r < 16; ++r) { const int d = d0 - ((r & 3) + 8 * (r >> 2)), e = d - 32;
                    p0[r] = (d >= 0) ? p0[r] * rf0 * cG[r] : 0.f; p1[r] = (e >= 0) ? p1[r] * rf1 * cG[r] : 0.f; }
            }
            u32x4 pw[4]; pack_p(pw, p0, p1); pv(o, kt + 8192, pw, lane);
        }
    }
    FA_BAR();
    issue_first(nx, pc, lds, wid, lane);
    scale_rows(o2, 0.125f * __builtin_amdgcn_exp2f(lg2 * (float)(i + 1)), wsf, r32, hi);
#pragma unroll
    for (int r = 0; r < 16; ++r) { o[0][r] += o2[0][r]; o[1][r] += o2[1][r]; }
    stage_o(o, stg, r32, hi);
    { const size_t m0 = (size_t)b * SEQ + tw0;
#pragma unroll
      for (int it = 0; it < 4; ++it) { const int row = it * 8 + (lane >> 3), c8 = lane & 7;
          const f32x4 a = *(const LAS f32x4*)(stg + row * 64 + c8 * 8), c = *(const LAS f32x4*)(stg + row * 64 + c8 * 8 + 4);
          float sm = (a.x + a.y) + (a.z + a.w) + (c.x + c.y) + (c.z + c.w);
          sm += xshfl<1>(sm); sm += xshfl<2>(sm); sm += xshfl<4>(sm);
          const float mu = sm * (1.f / 64.f); const f32x4 da = a - mu, dc = c - mu;
          float vs = (da.x * da.x + da.y * da.y) + (da.z * da.z + da.w * da.w) + (dc.x * dc.x + dc.y * dc.y) + (dc.z * dc.z + dc.w * dc.w);
          vs += xshfl<1>(vs); vs += xshfl<2>(vs); vs += xshfl<4>(vs);
          const float rs = rsqrtf(vs * (1.f / 64.f) + 1e-5f);
          const u32x4 z = zz[it];
          u32x4 w; w.x = cvt_pk_bf16(da.x * rs * siluf_(bflo(z.x)), da.y * rs * siluf_(bfhi(z.x))); w.y = cvt_pk_bf16(da.z * rs * siluf_(bflo(z.y)), da.w * rs * siluf_(bfhi(z.y)));
          w.z = cvt_pk_bf16(dc.x * rs * siluf_(bflo(z.z)), dc.y * rs * siluf_(bfhi(z.z))); w.w = cvt_pk_bf16(dc.z * rs * siluf_(bflo(z.w)), dc.w * rs * siluf_(bfhi(z.w)));
          *(u32x4*)(Y + (m0 + row) * DM + 768 + h * 64 + c8 * 8) = w; } }
}
__device__ __forceinline__ void nsa_unit(const bf16* P, const bf16* KCB, const bf16* VCB, bf16* Y, int unit, LAS unsigned char* lds, int tid, bool pre, const NextUnit& nx, const PreCtx& pc) {
    asm volatile("" : "+v"(tid));
    const int lane = tid & 63, wid = __builtin_amdgcn_readfirstlane(tid >> 6), r32 = lane & 31, hi = lane >> 5;
    const int b = unit >> 7, pos0 = ((b & 2) ? 127 - (unit & 127) : (unit & 127)) * 64, cur = pos0 >> 6;
    const bf16* Pb = P + (size_t)b * SEQ * PW;
    LAS float* OA = (LAS float*)(lds + L_STG); LAS unsigned* selm = (LAS unsigned*)(lds + L_SEL); LAS unsigned* uni = (LAS unsigned*)(lds + L_UNI); LAS float* wsf = (LAS float*)(lds + L_WSF) + wid * 64;
    LAS float* stg = OA + wid * 2048;
    const float scale2 = 0.125f * LOG2E;
    const int pl = r32 >> 2, h = r32 & 3, t = pos0 + 8 * wid + pl;
    const float slope2 = exp2f(-2.f * (float)(h + 1)) * LOG2E;
    bf16x8 qr[4];
#pragma unroll
    for (int d0 = 0; d0 < 4; ++d0) qr[d0] = *(const bf16x8*)(Pb + (size_t)t * PW + A_Q + h * 64 + d0 * 16 + hi * 8);
    const bf16 gl0 = Pb[(size_t)t * PW + A_G + 3 * h], gl1 = Pb[(size_t)t * PW + A_G + 3 * h + 1], gl2 = Pb[(size_t)t * PW + A_G + 3 * h + 2];
    u32x4 zz[4];
#pragma unroll
    for (int it = 0; it < 4; ++it) { const int row = 32 * wid + it * 8 + (lane >> 3); zz[it] = *(const u32x4*)(Pb + (size_t)(pos0 + (row >> 2)) * PW + A_Z + (row & 3) * 64 + (lane & 7) * 8); }
    for (int rep1_ = 0; rep1_ < NREP(10); ++rep1_) {
        const int ncvmax = (pos0 >> 5) + 2, ntile = (ncvmax + 63) >> 6;
        if (tid < 4) uni[tid] = 0u;
        if (!(pre && rep1_ == 0))
        for (int tl = 0; tl < ntile; ++tl) {
            __builtin_amdgcn_global_load_lds((const unsigned*)(KCB + ((size_t)b * 256 + 64 * tl + lane) * 64 + wid * 8), (LAS unsigned*)(lds + tl * 8192 + wid * 1024), 16, 0, 0);
            __builtin_amdgcn_global_load_lds((const unsigned*)(VCB + ((size_t)b * 256 + 64 * tl + 16 * (wid & 3) + (lane >> 2)) * 64 + (wid >> 2) * 32 + (lane & 3) * 8), (LAS unsigned*)(lds + 32768 + tl * 8192 + wid * 1024), 16, 0, 0); }
        FA_WAIT(0); FA_BAR();
        const int ncv = (t >= 31) ? (((t - 31) >> 5) + 1) : 0;
        float m = -1e30f, l = 0.f;
        for (int tl = 0; tl < ntile; ++tl) {
            f32x16 p0, p1; qkt(p0, p1, lds + tl * 8192, qr, r32, hi);
            const int c0 = 64 * tl + 4 * hi; float rm = -1e30f;
#pragma unroll
            for (int r = 0; r < 16; ++r) { const int c = c0 + (r & 3) + 8 * (r >> 2);
                p0[r] = (c < ncv) ? p0[r] * scale2 - slope2 * (float)(t - 32 * c - 31) : -1e30f; p1[r] = (c + 32 < ncv) ? p1[r] * scale2 - slope2 * (float)(t - 32 * (c + 32) - 31) : -1e30f;
                rm = fmaxf(rm, fmaxf(p0[r], p1[r])); }
            rm = xmax32(rm); const float mn = fmaxf(m, rm); float rs = 0.f;
#pragma unroll
            for (int r = 0; r < 16; ++r) { rs += (p0[r] > -1e29f ? __builtin_amdgcn_exp2f(p0[r] - mn) : 0.f) + (p1[r] > -1e29f ? __builtin_amdgcn_exp2f(p1[r] - mn) : 0.f); }
            l = l * __builtin_amdgcn_exp2f(m - mn) + xsum32(rs); m = mn;
        }
        const float inv = l > 0.f ? 1.f / l : 0.f;
        f32x16 o[2];
#pragma unroll
        for (int r = 0; r < 16; ++r) { o[0][r] = 0.f; o[1][r] = 0.f; }
        LAS float* impw = stg;
        for (int tl = 0; tl < ntile; ++tl) {
            f32x16 p0, p1; qkt(p0, p1, lds + tl * 8192, qr, r32, hi);
            const int c0 = 64 * tl + 4 * hi;
#pragma unroll
            for (int r = 0; r < 16; ++r) { const int c = c0 + (r & 3) + 8 * (r >> 2);
                p0[r] = (c < ncv) ? __builtin_amdgcn_exp2f(p0[r] * scale2 - slope2 * (float)(t - 32 * c - 31) - m) * inv : 0.f;
                p1[r] = (c + 32 < ncv) ? __builtin_amdgcn_exp2f(p1[r] * scale2 - slope2 * (float)(t - 32 * (c + 32) - 31) - m) * inv : 0.f; }
#pragma unroll
            for (int r = 0; r < 16; r += 2) { float a0 = p0[r] + p0[r + 1], a1 = p1[r] + p1[r + 1];
                a0 += xshfl<1>(a0); a0 += xshfl<2>(a0); a1 += xshfl<1>(a1); a1 += xshfl<2>(a1);
                const int jl = ((r & 3) >> 1) + 4 * (r >> 2) + 2 * hi;
                if (h == 0) { impw[pl * 128 + 32 * tl + jl] = a0; impw[pl * 128 + 32 * tl + 16 + jl] = a1; } }
            u32x4 pw[4]; pack_p(pw, p0, p1); pv(o, lds + 32768 + tl * 8192, pw, lane);
        }
        { const int pq = lane >> 3, sub = lane & 7; unsigned bits = 0u;
          if (cur <= 15) {
#pragma unroll
              for (int c = 0; c < 16; ++c) bits |= (sub * 16 + c <= cur) ? (1u << c) : 0u;
          } else {
              float cand[16]; const int kend = cur - 2;
#pragma unroll
              for (int c = 0; c < 16; ++c) { const int jc = sub * 16 + c; cand[c] = (jc >= 1 && jc <= kend) ? impw[pq * 128 + jc] : -1.f;
                  bits |= ((jc == 0) || (jc == cur) || (jc == cur - 1)) ? (1u << c) : 0u; }
              for (int round = 0; round < 13; ++round) {
                  float vm = cand[0];
#pragma unroll
                  for (int c = 1; c < 16; ++c) vm = fmaxf(vm, cand[c]);
                  vm = fmaxf(vm, __uint_as_float(__builtin_amdgcn_update_dpp(0, __float_as_uint(vm), 0xB1, 0xF, 0xF, true)));
                  vm = fmaxf(vm, __uint_as_float(__builtin_amdgcn_update_dpp(0, __float_as_uint(vm), 0x4E, 0xF, 0xF, true)));
                  vm = fmaxf(vm, __uint_as_float(__builtin_amdgcn_update_dpp(0, __float_as_uint(vm), 0x141, 0xF, 0xF, true)));
                  int idx = 255;
#pragma unroll
                  for (int c = 15; c >= 0; --c) idx = (cand[c] == vm) ? sub * 16 + c : idx;
                  idx = min(idx, (int)__builtin_amdgcn_update_dpp(0, (unsigned)idx, 0xB1, 0xF, 0xF, true));
                  idx = min(idx, (int)__builtin_amdgcn_update_dpp(0, (unsigned)idx, 0x4E, 0xF, 0xF, true));
                  idx = min(idx, (int)__builtin_amdgcn_update_dpp(0, (unsigned)idx, 0x141, 0xF, 0xF, true));
#pragma unroll
                  for (int c = 0; c < 16; ++c) { const bool hit = (sub * 16 + c == idx) && (vm >= 0.f); bits |= hit ? (1u << c) : 0u; cand[c] = hit ? -1.f : cand[c]; }
              }
          }
          ((LAS unsigned short*)selm)[(8 * wid + pq) * 8 + sub] = (unsigned short)bits;
          (void)__hip_atomic_fetch_or(uni + (sub >> 1), bits << (16 * (sub & 1)), __ATOMIC_RELAXED, __HIP_MEMORY_SCOPE_WORKGROUP); }
        const float g0 = sigmoidf_(bf2f(gl0));
        scale_rows(o, g0, wsf, r32, hi);
        stage_o(o, stg, r32, hi);
    }
    FA_WAIT(0); FA_BAR();
    {
        unsigned selw[4], un[4];
#pragma unroll
        for (int i = 0; i < 4; ++i) { selw[i] = selm[(8 * wid + pl) * 4 + i]; un[i] = __builtin_amdgcn_readfirstlane(uni[i]); }
        const float g1 = sigmoidf_(bf2f(gl1)), g2 = sigmoidf_(bf2f(gl2));
        float cK[16];
#pragma unroll
        for (int r = 0; r < 16; ++r) cK[r] = slope2 * (float)((r & 3) + 8 * (r >> 2));
        for (int rep2_ = 0; rep2_ < NREP(11); ++rep2_)
        for (int br = 0; br < 2; ++br) {
            const bf16* kb = Pb + A_KV + (br ? 256 : 128); const bf16* vb = kb + 64;
            float m = -1e30f, l = 0.f; f32x16 o[2];
#pragma unroll
            for (int r = 0; r < 16; ++r) { o[0][r] = 0.f; o[1][r] = 0.f; }
            const int jlow = br ? (cur >= 8 ? cur - 8 : 0) : 0;
            tile_stream(cur,
                [&](int j) { if (br) return j > jlow ? j - 1 : -1;
                             if (j <= 0) return -1;
                             const int q = j - 1; int w = q >> 5; unsigned mk = (w == 0 ? un[0] : w == 1 ? un[1] : w == 2 ? un[2] : un[3]) & (0xffffffffu >> (31 - (q & 31)));
                             for (;;) { if (mk) return w * 32 + 31 - __builtin_clz(mk); if (--w < 0) return -1; mk = (w == 0 ? un[0] : w == 1 ? un[1] : un[2]); } },
                [&](int j, int sl) { dma_tile(kb + (size_t)(64 * j) * PW, vb + (size_t)(64 * j) * PW, PW, lds + sl * SLOT, wid, lane); },
                [&](int j, int sl) {
                    const bool mine = br ? true : (((selw[j >> 5] >> (j & 31)) & 1u) != 0u);
                    if (__any(mine)) {
                        const LAS unsigned char* kt = lds + sl * SLOT;
                        f32x16 p0, p1; qkt(p0, p1, kt, qr, r32, hi);
                        const int d0 = t - (64 * j + 4 * hi);
                        if (br ? (j < cur && j > cur - 8) : (j < cur)) {
                            const float b0 = -slope2 * (float)d0, b1 = b0 + 32.f * slope2;
                            float rm0 = -1e30f, rm1 = -1e30f;
#pragma unroll
                            for (int r = 0; r < 16; ++r) { p0[r] = p0[r] * scale2 + cK[r]; p1[r] = p1[r] * scale2 + cK[r]; rm0 = fmaxf(rm0, p0[r]); rm1 = fmaxf(rm1, p1[r]); }
                            float rm = fmaxf(rm0 + b0, rm1 + b1); rm = mine ? rm : -1e30f; rm = xmax32(rm);
                            const float mn = (rm > m + 8.f) ? rm : m, f = __builtin_amdgcn_exp2f(m - mn); m = mn;
                            const float off0 = mine ? mn - b0 : 1e30f, off1 = mine ? mn - b1 : 1e30f; float rs = 0.f;
#pragma unroll
                            for (int r = 0; r < 16; ++r) { p0[r] = __builtin_amdgcn_exp2f(p0[r] - off0); p1[r] = __builtin_amdgcn_exp2f(p1[r] - off1); rs += p0[r] + p1[r]; }
                            l = l * f + xsum32(rs);
                            if (__any(f != 1.f)) scale_rows(o, f, wsf, r32, hi);
                        } else {
#pragma unroll
                            for (int r = 0; r < 16; ++r) { const int d = d0 - ((r & 3) + 8 * (r >> 2)), e = d - 32;
                                const bool v0 = br ? (d >= 0 && d < 512) : (mine && d >= 0), v1 = br ? (e >= 0 && e < 512) : (mine && e >= 0);
                                p0[r] = v0 ? p0[r] * scale2 - slope2 * (float)d : -1e30f; p1[r] = v1 ? p1[r] * scale2 - slope2 * (float)e : -1e30f; }
                            softmax_step(p0, p1, m, l, o, wsf, r32, hi);
                        }
                        u32x4 pw[4]; pack_p(pw, p0, p1); pv(o, kt + 8192, pw, lane);
                    } });
            scale_rows(o, rep2_ ? 0.f : (l > 0.f ? 1.f / l : 0.f) * (br ? g2 : g1), wsf, r32, hi);
#pragma unroll
            for (int r = 0; r < 16; ++r) { LAS float* orow = stg + crow(r, hi) * 64 + r32; orow[0] += o[0][r]; orow[32] += o[1][r]; }
        }
    }
    issue_first(nx, pc, lds, wid, lane);
    { const size_t mb = (size_t)b * SEQ + pos0;
#pragma unroll
      for (int it = 0; it < 4; ++it) { const int row = 32 * wid + it * 8 + (lane >> 3), c8 = lane & 7, pq = row >> 2, hh = row & 3;
          const f32x4 a = *(const LAS f32x4*)(OA + row * 64 + c8 * 8), c = *(const LAS f32x4*)(OA + row * 64 + c8 * 8 + 4);
          const u32x4 z = zz[it];
          u32x4 w; w.x = cvt_pk_bf16(a.x * siluf_(bflo(z.x)), a.y * siluf_(bfhi(z.x))); w.y = cvt_pk_bf16(a.z * siluf_(bflo(z.y)), a.w * siluf_(bfhi(z.y)));
          w.z = cvt_pk_bf16(c.x * siluf_(bflo(z.z)), c.y * siluf_(bfhi(z.z))); w.w = cvt_pk_bf16(c.z * siluf_(bflo(z.w)), c.w * siluf_(bfhi(z.w)));
          *(u32x4*)(Y + (mb + pq) * DM + hh * 64 + c8 * 8) = w; } }
}
__device__ __forceinline__ void ustate_unit(const bf16* P, float* U, int unit, LAS unsigned char* lds, int tid) {
    asm volatile("" : "+v"(tid));
    const int lane = tid & 63, wid = __builtin_amdgcn_readfirstlane(tid >> 6), r32 = lane & 31, hi = lane >> 5;
    const int b = unit >> 7, h = (unit >> 5) & 3, pos0 = (unit & 31) * 256, ch = wid >> 2, dh = (wid >> 1) & 1, eh = wid & 1;
    const bf16* kb = P + ((size_t)b * SEQ + pos0) * PW + D_K + h * 64; const bf16* vb = P + ((size_t)b * SEQ + pos0) * PW + D_V + h * 64;
    const size_t roff = (size_t)(16 * (wid & 3) + (lane >> 2)) * PW + (wid >> 2) * 32 + (lane & 3) * 8;
#pragma unroll
    for (int tt = 0; tt < 4; ++tt) {
        __builtin_amdgcn_global_load_lds((const unsigned*)(kb + (size_t)(64 * tt) * PW + roff), (LAS unsigned*)(lds + tt * SLOT + wid * 1024), 16, 0, 0);
        __builtin_amdgcn_global_load_lds((const unsigned*)(vb + (size_t)(64 * tt) * PW + roff), (LAS unsigned*)(lds + tt * SLOT + 8192 + wid * 1024), 16, 0, 0); }
    FA_WAIT(0); FA_BAR();
    const float lg2 = __builtin_amdgcn_logf(1.f - exp2f(-5.f - (float)h));
    f32x16 acc;
#pragma unroll
    for (int r = 0; r < 16; ++r) acc[r] = 0.f;
    const int voff = ((lane >> 4) & 1) * 32 + (lane & 3) * 8 + (4 * hi + ((lane & 15) >> 2)) * 64;
#pragma unroll
    for (int t2 = 0; t2 < 2; ++t2) { const LAS unsigned char* kt = lds + (2 * ch + t2) * SLOT + voff;
#pragma unroll
        for (int ks = 0; ks < 4; ++ks) {
            const s16x4 klo = vtr(kt + dh * 4096 + ks * 1024), khi = vtr(kt + dh * 4096 + ks * 1024 + 512), vlo = vtr(kt + 8192 + eh * 4096 + ks * 1024), vhi = vtr(kt + 8192 + eh * 4096 + ks * 1024 + 512);
            const int jb = 64 * t2 + 16 * ks + 4 * hi; float kz[8];
#pragma unroll
            for (int e = 0; e < 4; ++e) { kz[e] = bf2f((bf16)klo[e]) * __builtin_amdgcn_exp2f(lg2 * (float)(127 - (jb + e))); kz[4 + e] = bf2f((bf16)khi[e]) * __builtin_amdgcn_exp2f(lg2 * (float)(127 - (jb + 8 + e))); }
            const u32x4 kw = (u32x4){cvt_pk_bf16(kz[0], kz[1]), cvt_pk_bf16(kz[2], kz[3]), cvt_pk_bf16(kz[4], kz[5]), cvt_pk_bf16(kz[6], kz[7])};
            const bf16x8 vf = (bf16x8){vlo[0], vlo[1], vlo[2], vlo[3], vhi[0], vhi[1], vhi[2], vhi[3]};
            acc = __builtin_amdgcn_mfma_f32_32x32x16_bf16(__builtin_bit_cast(bf16x8, kw), vf, acc, 0, 0, 0); } }
    float* ud = U + ((((size_t)b * 64 + (pos0 >> 7) + ch) * 4 + h) * 64 + 32 * dh) * 64 + 32 * eh + r32;
#pragma unroll
    for (int r = 0; r < 16; ++r) st_wt(ud + (size_t)crow(r, hi) * 64, acc[r]);
    FA_BAR();
}
}

typedef const __attribute__((address_space(4))) Args* KArgs;
#define PH_PTRS() KArgs kp = ka; asm volatile("" : "+s"(kp)); unsigned char* const ws = kp->ws; (void)ws; int tid = (wave << 6) | lane_id_now(); const int lane = tid & 63; (void)lane; int gwl = gw; asm volatile("" : "+s"(gwl)); (void)gwl
__global__ void __launch_bounds__(NTHREADS, 2) hybrid_fwd(Args args_byval) {
    extern __shared__ __attribute__((aligned(16))) unsigned char lds_raw[];
    LAS unsigned char* lds = (LAS unsigned char*)lds_raw;
    volatile LAS unsigned* MISC = (volatile LAS unsigned*)(lds + MISC_OFF);
    const KArgs ka = (KArgs)__builtin_amdgcn_kernarg_segment_ptr();
    const int tid0 = threadIdx.x, wave = __builtin_amdgcn_readfirstlane(tid0 >> 6);
    const int G = gridDim.x, gw = blockIdx.x * NWAVES + wave, NGW = G * NWAVES;
    const int vcu = (G % 8 == 0) ? ((int)blockIdx.x % 8) * (G / 8) + (int)blockIdx.x / 8 : (int)blockIdx.x;
    for (int u = tid0; u < (LDS_BYTES - LDSCTL_OFF) / 4; u += NTHREADS) ((LAS unsigned*)(lds + LDSCTL_OFF))[u] = 0u;
    __syncthreads();
    XcdBarrier bar; bar.bar = (unsigned*)(args_byval.ws + WS_CTL) + CW_BAR; bar.x = 0; bar.st = nullptr;
    if (MK_N_LAUNCHES == 1) bar = xcd_barrier_post(bar.bar, MISC + 8);
    bar.wave = wave;
#if MK_N_LAUNCHES == 1
#define IN(k) true
#else
    const int lo = args_byval.ph_lo, hi = args_byval.ph_hi;
#define IN(k) (lo <= (k) && (k) < hi)
#endif
#define SEAM(k) do { if (IN(k) && IN((k) + 1)) { if (MK_N_LAUNCHES == 1) { for (int rb_ = 0; rb_ < NREP(12); ++rb_) xcd_barrier(bar); } } } while (0)
    LAS float* wl = (LAS float*)(lds + wave * 8192);

    if (IN(0)) {
        PH_PTRS();
        bf16* WIN_T = (bf16*)(ws + WS_WIN); bf16* WCAT_T = (bf16*)(ws + WS_WCAT); bf16* WO_T = (bf16*)(ws + WS_WO); float* MOD = (float*)(ws + WS_MOD);
        LAS float* scr = (LAS float*)(lds + wave * 16384);
        constexpr int I_WIN = DEPTH * 16 * 120, I_G = 16 * 16 * 32, I_B = 16 * 4 * 32, I_O = DEPTH * 16 * 32, I_W1 = DEPTH * 2 * 32 * 2, I_P1 = DEPTH * 2 * 8;
        for (int rep_ = 0; rep_ < NREP(0); ++rep_)
        for (int it = gwl; it < I_WIN + I_G + I_B + I_O + I_W1 + I_P1; it += NGW) {
            int r = it;
            if (r >= I_WIN + I_G + I_B + I_O) { r -= I_WIN + I_G + I_B + I_O;
                if (r < I_W1) { const int mat = r >> 6, q = r & 63; transpose_item<false>(kp->cmp_w1 + (size_t)mat * 2048 * 64, 64, (bf16*)(ws + WS_W1T) + (size_t)mat * 64 * 2048, 2048, 0, scr, q >> 1, q & 1, lane); continue; }
                r -= I_W1; { const int mat = r >> 3, sl = r & 7; const float* w1 = kp->cmp_w1 + ((size_t)mat * 2048 + 256 * sl) * 64 + lane; const float* pos = kp->cmp_pos + (size_t)mat * 2048 + 256 * sl; float a = 0.f;
#pragma unroll 8
                    for (int i = 0; i < 256; ++i) a += pos[i] * w1[(size_t)i * 64];
                    ((float*)(ws + WS_B1P))[(mat * 8 + sl) * 64 + lane] = a; }
                continue; }
            if (r < I_WIN) { const int l = r / (16 * 120), q = r % (16 * 120); transpose_item<true>(kp->w_in + (size_t)l * DM * INW, INW, WIN_T + (size_t)l * PW * DM, DM, 0, scr, q / 120, q % 120, lane); continue; } r -= I_WIN;
            if (r < I_G) { const int li = r / 512, q = r % 512; transpose_item<false>(kp->w_merge + (size_t)li * DM * DM, DM, WCAT_T + (size_t)li * DM * KCAT, KCAT, 0, scr, q / 32, q % 32, lane); continue; } r -= I_G;
            if (r < I_B) { const int li = r / 128, q = r % 128; transpose_item<false>(kp->w_br + (size_t)li * 256 * DM, DM, WCAT_T + (size_t)li * DM * KCAT, KCAT, 1024, scr, q / 32, q % 32, lane); continue; } r -= I_B;
            { const int l = r / 512, q = r % 512; transpose_item<false>(kp->w_out + (size_t)l * DM * DM, DM, WO_T + (size_t)l * DM * DM, DM, 0, scr, q / 32, q % 32, lane); }
        }
        __syncthreads();
        LAS float* red = (LAS float*)lds;
        const float* cvec = kp->c;
        for (int rep_ = 0; rep_ < NREP(13); ++rep_)
        for (int u = blockIdx.x; u < DEPTH * 48; u += G) {
            const int l = u / 48, col = (u % 48) * 64 + lane; float a[4] = {0.f, 0.f, 0.f, 0.f};
            const float* wa = kp->w_ada + (size_t)l * DM * 3072 + col;
            for (int k0 = wave * 128; k0 < wave * 128 + 128; k0 += 16) { float wv[16];
#pragma unroll
                for (int i = 0; i < 16; ++i) wv[i] = wa[(size_t)(k0 + i) * 3072];
#pragma unroll
                for (int i = 0; i < 16; ++i)
#pragma unroll
                    for (int b = 0; b < 4; ++b) a[b] += siluf_(cvec[b * DM + k0 + i]) * wv[i]; }
#pragma unroll
            for (int b = 0; b < 4; ++b) red[(wave * 4 + b) * 64 + lane] = a[b];
            __syncthreads();
            if (wave < 4) { float s = kp->b_ada[(size_t)l * 3072 + col];
#pragma unroll
                for (int w = 0; w < 8; ++w) s += red[(w * 4 + wave) * 64 + lane];
                MOD[((size_t)l * 4 + wave) * 3072 + col] = s; }
            __syncthreads();
        }
    }
    SEAM(0);
    if (IN(1)) {
        PH_PTRS();
        const float* MOD = (const float*)(ws + WS_MOD);
        float* GS = (float*)(ws + WS_GS);
        for (int idx = blockIdx.x * NTHREADS + tid; idx < DEPTH * NBATCH * DM; idx += G * NTHREADS) { const int lb = idx >> 10, c = idx & 1023; GS[idx] = kp->norm_g[(lb >> 2) * DM + c] * (1.f + MOD[(size_t)lb * 3072 + 1024 + c]); }
        constexpr int T_IN = DEPTH * PW, T_MG = DEPTH * 4096;
        for (int tb = 4 * gwl; tb < T_IN + T_MG; tb += 4 * NGW) {
            u32x4 w0[4], w1[4];
#pragma unroll
            for (int q = 0; q < 4; ++q) { const int task = tb + q; const bf16* wrow;
                if (task < T_IN) wrow = (const bf16*)(ws + WS_WIN) + (size_t)task * DM; else wrow = (const bf16*)(ws + WS_WCAT) + (size_t)(task - T_IN) * KCAT;
                w0[q] = *(const u32x4*)(wrow + 8 * lane); w1[q] = *(const u32x4*)(wrow + 512 + 8 * lane); }
#pragma unroll
            for (int q = 0; q < 4; ++q) { const int task = tb + q; int l, n; float* dst; int dpitch;
                if (task < T_IN) { l = task / PW; n = task % PW; dst = (float*)(ws + WS_SW) + (size_t)l * NBATCH * PW + n; dpitch = PW; }
                else { const int qq = task - T_IN; l = qq >> 12; n = qq & 4095; dst = (float*)(ws + WS_SWM) + (size_t)l * NBATCH * 4096 + n; dpitch = 4096; }
                const float wv[16] = {bflo(w0[q].x), bfhi(w0[q].x), bflo(w0[q].y), bfhi(w0[q].y), bflo(w0[q].z), bfhi(w0[q].z), bflo(w0[q].w), bfhi(w0[q].w), bflo(w1[q].x), bfhi(w1[q].x), bflo(w1[q].y), bfhi(w1[q].y), bflo(w1[q].z), bfhi(w1[q].z), bflo(w1[q].w), bfhi(w1[q].w)};
#pragma unroll
                for (int b = 0; b < NBATCH; ++b) { const float* sh = MOD + ((size_t)l * 4 + b) * 3072; float a = 0.f;
                    const f32x4 a0 = *(const f32x4*)(sh + 8 * lane), a1 = *(const f32x4*)(sh + 8 * lane + 4), a2 = *(const f32x4*)(sh + 512 + 8 * lane), a3 = *(const f32x4*)(sh + 512 + 8 * lane + 4);
                    a += wv[0] * a0.x + wv[1] * a0.y + wv[2] * a0.z + wv[3] * a0.w + wv[4] * a1.x + wv[5] * a1.y + wv[6] * a1.z + wv[7] * a1.w;
                    a += wv[8] * a2.x + wv[9] * a2.y + wv[10] * a2.z + wv[11] * a2.w + wv[12] * a3.x + wv[13] * a3.y + wv[14] * a3.z + wv[15] * a3.w;
                    a = wave_sum(a); if (lane == 0) dst[(size_t)b * dpitch] = a; } }
        }
        { const float* x = kp->x; const float* g = kp->norm_g; bf16* XN = (bf16*)(ws + WS_XN); float* SSQ = (float*)(ws + WS_SSQ);
          for (int m = gwl; m < MROWS; m += NGW) {
              const int b = m >> 13; const f32x4* xr = (const f32x4*)(x + (size_t)m * DM) + lane; f32x4 v[4]; float ss = 0.f;
#pragma unroll
              for (int j = 0; j < 4; ++j) { v[j] = xr[64 * j]; ss += v[j].x * v[j].x + v[j].y * v[j].y + v[j].z * v[j].z + v[j].w * v[j].w; }
              ss = wave_sum(ss); if (lane == 0) *(f32x4*)(SSQ + (size_t)m * 4) = (f32x4){ss, 0.f, 0.f, 0.f};
              u32x2* o8 = (u32x2*)(XN + (size_t)m * DM) + lane;
#pragma unroll
              for (int j = 0; j < 4; ++j) { const int col = 4 * (lane + 64 * j); const f32x4 gg = *(const f32x4*)(g + col), sc = *(const f32x4*)(MOD + (size_t)b * 3072 + 1024 + col);
                  const f32x4 hh = v[j] * gg * (sc + 1.f); u32x2 w; w.x = pk2(hh.x, hh.y); w.y = pk2(hh.z, hh.w); o8[64 * j] = w; } } }
    }
    SEAM(1);

    for (int l = 0; l < DEPTH; ++l) {
        const int pb = 2 + l * PH_PER_LAYER - 1;
        if (IN(pb + 1)) {
            PH_PTRS();
            pg8::PlainOrderT<WGM_G1, MROWS / 256, PW / 256> S{(const char*)(ws + WS_XN), (const char*)(ws + WS_WIN) + (size_t)l * PW * DM * 2, 16, G, (int)blockIdx.x, (size_t)DM, (size_t)DM};
            pg8::EpiP E{(bf16*)(ws + WS_P), (const float*)(ws + WS_SSQ), (const float*)(ws + WS_SW) + (size_t)l * NBATCH * PW, lds + L_GSLOT};
            for (int rep_ = 0; rep_ < NREP(2); ++rep_) { pg8::gemm_phase<pg8::EpiP, pg8::PlainOrderT<WGM_G1, MROWS / 256, PW / 256>, true>(lds, DM, DM, S, E, tid); }
            if (NREP(18) > 1) { pg8::EpiNull EN{(float*)(ws + WS_Y)}; pg8::gemm_phase<pg8::EpiNull, pg8::PlainOrderT<WGM_G1, MROWS / 256, PW / 256>, true>(lds, DM, DM, S, EN, tid); }
        }
        SEAM(pb + 1);
        if (IN(pb + 2)) {
            PH_PTRS();
            const bf16* P = (const bf16*)(ws + WS_P); bf16* Y = (bf16*)(ws + WS_Y); float* U = (float*)(ws + WS_U);
            unsigned* cnts = (unsigned*)(ws + WS_CTL) + CW_CNT + l * 4 * 64; (void)cnts;
            for (int rep_ = 0; rep_ < NREP(3); ++rep_)
            for (int u = blockIdx.x; u < 64; u += G) {
                const int jj = u >> 5, b = (u >> 3) & 3, c0 = (u & 7) * 32, mat = l * 2 + jj, r32 = lane & 31, hi = lane >> 5;
                __syncthreads();
                fa::f32x16 acc[2];
#pragma unroll
                for (int r = 0; r < 16; ++r) { acc[0][r] = 0.f; acc[1][r] = 0.f; }
                const bf16* zrow = P + ((size_t)b * SEQ + (size_t)(c0 + r32) * 32 + 4 * wave) * PW + A_KV + 64 * jj + 8 * hi;
                const bf16* wrow = (const bf16*)(ws + WS_W1T) + ((size_t)mat * 64 + r32) * 2048 + 256 * wave + 8 * hi;
#pragma unroll 4
                for (int ks = 0; ks < 16; ++ks) {
                    const bf16x8 af = *(const bf16x8*)(zrow + (size_t)(ks >> 2) * PW + 16 * (ks & 3));
                    const bf16x8 b0 = *(const bf16x8*)(wrow + 16 * ks), b1 = *(const bf16x8*)(wrow + 32 * 2048 + 16 * ks);
                    acc[0] = __builtin_amdgcn_mfma_f32_32x32x16_bf16(af, b0, acc[0], 0, 0, 0); acc[1] = __builtin_amdgcn_mfma_f32_32x32x16_bf16(af, b1, acc[1], 0, 0, 0); }
                LAS float* red = (LAS float*)lds + wave * 2048;
#pragma unroll
                for (int r = 0; r < 16; ++r) { const int row = fa::crow(r, hi); red[row * 64 + r32] = acc[0][r]; red[row * 64 + 32 + r32] = acc[1][r]; }
                __syncthreads();
                LAS float* hidL = (LAS float*)(lds + 65536);
                const float* b1p = (const float*)(ws + WS_B1P) + mat * 512;
#pragma unroll
                for (int q = 0; q < 4; ++q) { const int idx = tid + 512 * q, e = idx & 63; float sacc = 0.f;
#pragma unroll
                    for (int w = 0; w < 8; ++w) sacc += ((LAS float*)lds)[w * 2048 + idx] + b1p[w * 64 + e];
                    hidL[idx] = siluf_(sacc); }
                __syncthreads();
                LAS float* w2L = (LAS float*)(lds + 65536 + 8192);
                { const float* w2 = kp->cmp_w2 + (size_t)mat * 4096; const f32x4 wa = *(const f32x4*)(w2 + 8 * tid), wb = *(const f32x4*)(w2 + 8 * tid + 4);
                  *(LAS f32x4*)(w2L + 8 * tid) = wa; *(LAS f32x4*)(w2L + 8 * tid + 4) = wb; }
                __syncthreads();
#pragma unroll
                for (int q = 0; q < 2; ++q) { const int idx = tid + 512 * q, row = idx >> 5, e = 2 * (idx & 31); float o0 = 0.f, o1 = 0.f;
#pragma unroll 8
                    for (int d = 0; d < 64; ++d) { const f32x2 w = *(const LAS f32x2*)(w2L + d * 64 + e); const float hv = hidL[row * 64 + d]; o0 += hv * w.x; o1 += hv * w.y; }
                    st_wt((unsigned*)((bf16*)(ws + (jj ? WS_VCB : WS_KCB)) + ((size_t)b * 256 + c0 + row) * 64 + e), pk2(o0, o1)); }
            }
            if (MIX_MERGE) { if (blockIdx.x < 64) publish_count(cnts + 0 * 64, tid == 0); }
            __syncthreads();
            for (int rep_ = 0; rep_ < NREP(4); ++rep_) { if (G > 128) { if ((int)blockIdx.x >= 64) for (int u = (int)blockIdx.x - 64; u < 512; u += G - 64) fa::ustate_unit(P, U, u, lds, tid); } else { for (int u = vcu; u < 512; u += G) fa::ustate_unit(P, U, u, lds, tid); } }
            if (MIX_MERGE) publish_count(cnts + 1 * 64, tid == 0); else __syncthreads();
            const float* sink = kp->sink + l * 4;
            const fa::PreCtx pc{P, (const bf16*)(ws + WS_KCB), (const bf16*)(ws + WS_VCB), (const float*)(ws + WS_U)}; const fa::NextUnit none{fa::K_NONE, 0, false};
            bool pre = false;
            for (int rep_ = 0; rep_ < NREP(5); ++rep_) { for (int u = vcu; u < 512; u += G) { const fa::NextUnit nx = !XPRE ? none : (u + G < 512) ? fa::NextUnit{fa::K_SWA, u + G, false} : fa::NextUnit{fa::K_STICK, vcu, false};
                fa::swa_unit(P, sink, Y, u, lds, tid, pre, nx, pc); pre = XPRE; } }
            for (int rep_ = 0; rep_ < NREP(6); ++rep_) { for (int u = vcu; u < 512; u += G) { const fa::NextUnit nx = !XPRE ? none : (u + G < 512) ? fa::NextUnit{fa::K_STICK, u + G, false} : fa::NextUnit{fa::K_NSA_TOUCH, vcu, false};
                fa::stick_unit(P, Y, u, lds, tid, pre, nx, pc); pre = XPRE && (u + G < 512); } }
        }
        if (!MIX_MERGE) SEAM(pb + 2);
        if (IN(pb + 3)) {
            PH_PTRS();
            float* U = (float*)(ws + WS_U);
            unsigned* cnts = (unsigned*)(ws + WS_CTL) + CW_CNT + l * 4 * 64; (void)cnts;
            if (MIX_MERGE) wait_count(cnts + 1 * 64, (unsigned)G, wave);
            for (int gid = blockIdx.x * NTHREADS + tid; gid < 65536; gid += G * NTHREADS) {
                const int bh = gid >> 12, b = bh >> 2, h = bh & 3, de = gid & 4095;
                const float gch = __expf(logf(1.f - exp2f(-5.f - (float)h)) * 128.f); float r = 0.f;
                float* up = U + (((size_t)b * 64) * 4 + h) * 4096 + de;
                for (int n0 = 0; n0 < 64; n0 += 32) { float uv[32];
#pragma unroll
                    for (int i = 0; i < 32; ++i) uv[i] = up[(size_t)(n0 + i) * 4 * 4096];
#pragma unroll
                    for (int i = 0; i < 32; ++i) { st_wt(up + (size_t)(n0 + i) * 4 * 4096, r); r = r * gch + uv[i]; } }
            }
            if (MIX_MERGE) { publish_count(cnts + 2 * 64, tid == 0); wait_count(cnts + 0 * 64, 64u, wave); } else __syncthreads();
            const fa::PreCtx pc{(const bf16*)(ws + WS_P), (const bf16*)(ws + WS_KCB), (const bf16*)(ws + WS_VCB), (const float*)(ws + WS_U)}; const fa::NextUnit none{fa::K_NONE, 0, false};
            bool pre = false;
            for (int rep_ = 0; rep_ < NREP(7); ++rep_) { for (int u = vcu; u < 512; u += G) { const fa::NextUnit nx = !XPRE ? none : (u + G < 512) ? fa::NextUnit{fa::K_NSA, u + G, false} : fa::NextUnit{fa::K_RET, vcu, false};
                fa::nsa_unit(pc.P, pc.KCB, pc.VCB, (bf16*)(ws + WS_Y), u, lds, tid, pre, nx, pc); pre = XPRE; } }
        }
        if (!MIX_MERGE) SEAM(pb + 3);
        if (IN(pb + 4)) {
            PH_PTRS();
            if (MIX_MERGE) wait_count((unsigned*)(ws + WS_CTL) + CW_CNT + (l * 4 + 2) * 64, (unsigned)G, wave);
            const fa::PreCtx pc{(const bf16*)(ws + WS_P), (const bf16*)(ws + WS_KCB), (const bf16*)(ws + WS_VCB), (const float*)(ws + WS_U)}; const fa::NextUnit none{fa::K_NONE, 0, false};
            bool pre = XPRE;
            for (int rep_ = 0; rep_ < NREP(8); ++rep_) { for (int u = vcu; u < 512; u += G) { const fa::NextUnit nx = (XPRE && u + G < 512) ? fa::NextUnit{fa::K_RET, u + G, true} : none;
                fa::ret_unit(pc.P, pc.R, (bf16*)(ws + WS_Y), u, lds, tid, pre, nx, pc); pre = XPRE && (u + G < 512); } }
        }
        SEAM(pb + 4);
        if (IN(pb + 5)) {
            PH_PTRS();
            pg8::PostOrder S{(const char*)(ws + WS_XN), (const char*)(ws + WS_Y), (const char*)(ws + WS_WCAT) + (size_t)l * 4 * DM * KCAT * 2, G, (int)blockIdx.x};
            pg8::EpiPost E{(bf16*)(ws + WS_MERGED), (u32x4*)(ws + WS_SCR + (size_t)blockIdx.x * 262144), (const float*)(ws + WS_SSQ), (const float*)(ws + WS_SWM) + (size_t)l * NBATCH * 4096, lds + L_GSLOT, tid};
            for (int rep_ = 0; rep_ < NREP(9); ++rep_) { pg8::gemm_phase<pg8::EpiPost, pg8::PostOrder, true>(lds, DM, KCAT, S, E, tid); }
            if (NREP(17) > 1) { pg8::EpiNull EN{(float*)(ws + WS_P + 200 * MiB)}; pg8::gemm_phase<pg8::EpiNull, pg8::PostOrder, true>(lds, DM, KCAT, S, EN, tid); }
        }
        SEAM(pb + 5);
        if (IN(pb + 6)) {
            PH_PTRS();
            pg8::PlainOrderT<WGM_OUT, MROWS / 256, DM / 256> S{(const char*)(ws + WS_MERGED), (const char*)(ws + WS_WO) + (size_t)l * DM * DM * 2, 16, G, (int)blockIdx.x, (size_t)DM, (size_t)DM};
            bf16* XB = (bf16*)((char*)kp->out + 64 * MiB);
            bf16* XF = (bf16*)(ws + WS_XF);
            const float* gate = (const float*)(ws + WS_MOD) + (size_t)l * 4 * 3072 + 2048; const float* gsn = (l + 1 < DEPTH) ? (const float*)(ws + WS_GS) + (size_t)(l + 1) * NBATCH * DM : (const float*)nullptr;
            if (l == 0) { pg8::EpiOutT<false, true> E{kp->x, XB, XB, gate, (bf16*)(ws + WS_XN), gsn, (float*)(ws + WS_SSQ), (LAS float*)(lds + 132096), tid};
                pg8::gemm_phase<pg8::EpiOutT<false, true>, pg8::PlainOrderT<WGM_OUT, MROWS / 256, DM / 256>, true>(lds, DM, DM, S, E, tid); }
            else { pg8::EpiOutT<true, true> E{kp->x, XB, (l + 1 < DEPTH) ? XB : XF, gate, (bf16*)(ws + WS_XN), gsn, (float*)(ws + WS_SSQ), (LAS float*)(lds + 132096), tid};
                pg8::gemm_phase<pg8::EpiOutT<true, true>, pg8::PlainOrderT<WGM_OUT, MROWS / 256, DM / 256>, true>(lds, DM, DM, S, E, tid); }
            if (NREP(19) > 1) { pg8::EpiNull EN{(float*)(ws + WS_P + 200 * MiB)}; pg8::gemm_phase<pg8::EpiNull, pg8::PlainOrderT<WGM_OUT, MROWS / 256, DM / 256>, true>(lds, DM, DM, S, EN, tid); }
        }
        SEAM(pb + 6);
    }
    if (IN(NPH - 1)) {
        PH_PTRS();
        float* out = kp->out; const float* fg = kp->final_g; const bf16* xf = (const bf16*)(ws + WS_XF);
        for (int m = gwl; m < MROWS; m += NGW) {
            const u32x4* xi = (const u32x4*)(xf + (size_t)m * DM) + lane; f32x4 v[4]; float ss = 0.f;
#pragma unroll
            for (int j = 0; j < 2; ++j) { const u32x4 w = xi[64 * j]; v[2 * j] = (f32x4){bflo(w.x), bfhi(w.x), bflo(w.y), bfhi(w.y)}; v[2 * j + 1] = (f32x4){bflo(w.z), bfhi(w.z), bflo(w.w), bfhi(w.w)}; }
#pragma unroll
            for (int j = 0; j < 4; ++j) ss += v[j].x * v[j].x + v[j].y * v[j].y + v[j].z * v[j].z + v[j].w * v[j].w;
            const float r = rsqrtf(wave_sum(ss) * (1.f / DM) + 1e-6f);
#pragma unroll
            for (int j = 0; j < 4; ++j) { const int c4 = 128 * (j >> 1) + 2 * lane + (j & 1); const f32x4 gg = *(const f32x4*)(fg + 4 * c4); *((f32x4*)(out + (size_t)m * DM) + c4) = (v[j] * r) * gg; }
        }
    }
#undef IN
#undef SEAM
}

extern "C" void kernel_launch(void* const* d_in, const int* in_sizes, int n_in, void* d_out, int out_size, void* d_ws, size_t ws_size, hipStream_t stream) {
    static int grid = 0;
    if (grid == 0) {
        if (n_in != 14 || out_size != MROWS * DM || ws_size < WS_END) { fprintf(stderr, "kernel_launch: unexpected problem (n_in %d, out %d, ws %zu)\n", n_in, out_size, ws_size); grid = -1; return; }
        int dev = 0, cus = 0, per_cu = 0;
        if (hipGetDevice(&dev) != hipSuccess || hipDeviceGetAttribute(&cus, hipDeviceAttributeMultiprocessorCount, dev) != hipSuccess) { grid = -1; return; }
        if (hipFuncSetAttribute((const void*)hybrid_fwd, hipFuncAttributeMaxDynamicSharedMemorySize, LDS_BYTES) != hipSuccess) { fprintf(stderr, "kernel_launch: hipFuncSetAttribute failed\n"); grid = -1; return; }
        if (hipOccupancyMaxActiveBlocksPerMultiprocessor(&per_cu, (const void*)hybrid_fwd, NTHREADS, LDS_BYTES) != hipSuccess || per_cu < 1) fprintf(stderr, "kernel_launch: occupancy query reports %d\n", per_cu);
        (void)hipGetLastError();
        grid = cus;
    }
    if (grid < 0) return;
    if (hipMemsetAsync((char*)d_ws + WS_CTL, 0, CTL_ZERO_BYTES, stream) != hipSuccess) return;
    Args a{};
    a.x = (const float*)d_in[0]; a.c = (const float*)d_in[1]; a.w_ada = (const float*)d_in[2]; a.b_ada = (const float*)d_in[3]; a.norm_g = (const float*)d_in[4]; a.w_in = (const float*)d_in[5];
    a.cmp_pos = (const float*)d_in[6]; a.cmp_w1 = (const float*)d_in[7]; a.cmp_w2 = (const float*)d_in[8]; a.sink = (const float*)d_in[9]; a.w_merge = (const float*)d_in[10]; a.w_br = (const float*)d_in[11];
    a.w_out = (const float*)d_in[12]; a.final_g = (const float*)d_in[13];
    a.out = (float*)d_out; a.ws = (unsigned char*)d_ws;
    if (MK_N_LAUNCHES == 1) { a.ph_lo = 0; a.ph_hi = NPH; a.li = 0; hipLaunchKernelGGL(hybrid_fwd, dim3(grid), dim3(NTHREADS), LDS_BYTES, stream, a); }
    else for (int p = 0; p < NPH; ++p) { a.ph_lo = p; a.ph_hi = p + 1; a.li = p; hipLaunchKernelGGL(hybrid_fwd, dim3(grid), dim3(NTHREADS), LDS_BYTES, stream, a); }
}
```

```cpp
#include <hip/hip_runtime.h>
#include <cstdio>
#include <cstdint>

#define GAS __attribute__((address_space(1)))
#define LAS __attribute__((address_space(3)))
typedef unsigned short bf16;
typedef unsigned u32x4 __attribute__((ext_vector_type(4)));
typedef unsigned u32x2 __attribute__((ext_vector_type(2)));
typedef float f32x4 __attribute__((ext_vector_type(4)));
typedef float f32x2 __attribute__((ext_vector_type(2)));
typedef short bf16x8 __attribute__((ext_vector_type(8)));

#ifndef DBG_REP
#define DBG_REP 0
#endif
#define NREP(k) (((DBG_REP >> (k)) & 1) ? 2 : 1)
#ifndef XPRE
#define XPRE (DBG_REP == 0)
#endif
#ifndef WGM_G1
#define WGM_G1 4
#endif
#ifndef WGM_POST_V
#define WGM_POST_V 8
#endif
#ifndef WGM_OUT
#define WGM_OUT 8
#endif
#ifndef MIX_MERGE
#define MIX_MERGE 1
#endif
#ifndef MK_N_LAUNCHES
#define MK_N_LAUNCHES 1
#endif

constexpr int DM = 1024, NBATCH = 4, SEQ = 8192, DEPTH = 4, MROWS = NBATCH * SEQ;
constexpr int INW = 3724, PW = 3840;
constexpr int A_Q = 0, A_KV = 256, A_Z = 640, B_Q = 896, B_K = 1152, B_V = 1280, B_Z = 1408;
constexpr int C_Q = 1664, C_K = 1920, C_V = 2176, C_Z = 2432, D_Q = 2688, D_K = 2944, D_V = 3200, D_Z = 3456, A_G = 3712;
constexpr int KCAT = 1280;
constexpr int NWAVES = 8, NTHREADS = 512;
constexpr int PH_PER_LAYER = 6, NPH = 3 + DEPTH * PH_PER_LAYER;

constexpr size_t MiB = 1u << 20;
constexpr size_t WS_CTL = 0, CTL_ZERO_BYTES = 65536;
constexpr size_t WS_MOD = 1 * MiB;
constexpr size_t WS_KC = 2 * MiB, WS_VC = 2 * MiB + 262144;
constexpr size_t WS_KCB = 2 * MiB + 524288, WS_VCB = 2 * MiB + 655360;
constexpr size_t WS_WIN = 4 * MiB;
constexpr size_t WS_WCAT = 34 * MiB;
constexpr size_t WS_WO = 74 * MiB;
constexpr size_t WS_XN = 82 * MiB;
constexpr size_t WS_Y = 146 * MiB;
constexpr size_t WS_U = 210 * MiB;
constexpr size_t WS_P = 226 * MiB;
constexpr size_t WS_MERGED = WS_P;
constexpr size_t WS_XF = WS_P + 64 * MiB;
constexpr size_t WS_SCR = WS_P + 64 * MiB;
constexpr size_t WS_W1T = 466 * MiB;
constexpr size_t WS_B1P = 3 * MiB;
constexpr size_t WS_GS = 3 * MiB + 65536;
constexpr size_t WS_SW = 3 * MiB + 131072;
constexpr size_t WS_SWM = 3 * MiB + 393216;
constexpr size_t WS_SSQ = 468 * MiB;
constexpr size_t WS_END = 469 * MiB;
constexpr int CW_TMO = 0, CW_BAR = 4096, CW_CNT = 8192;

constexpr int RING_BYTES = 131072;
constexpr int LDSCTL_OFF = RING_BYTES, MISC_OFF = LDSCTL_OFF + 320;
constexpr int LDS_BYTES = 163840;
constexpr int L_GSLOT = 132096, L_EPT = L_GSLOT + 24576;

__device__ __forceinline__ float bf2f(bf16 u) { return __uint_as_float((unsigned)u << 16); }
__device__ __forceinline__ float bflo(unsigned w) { return __uint_as_float(w << 16); }
__device__ __forceinline__ float bfhi(unsigned w) { return __uint_as_float(w & 0xffff0000u); }
__device__ __forceinline__ unsigned f2bf(float f) { unsigned u = __float_as_uint(f); return (u + 0x7fffu + ((u >> 16) & 1u)) >> 16; }
__device__ __forceinline__ unsigned pk2(float lo, float hi) { return f2bf(lo) | (f2bf(hi) << 16); }
typedef __bf16 bf16x2_t __attribute__((ext_vector_type(2)));
__device__ __forceinline__ unsigned cvt_pk_bf16(float lo, float hi) { const f32x2 v = {lo, hi}; const bf16x2_t b = __builtin_convertvector(v, bf16x2_t); return __builtin_bit_cast(unsigned, b); }
template <int M> __device__ __forceinline__ float xshfl(float v) {
    static_assert(M == 1 || M == 2 || M == 4 || M == 8 || M == 16, "xshfl mask");
    if (M == 1) return __uint_as_float(__builtin_amdgcn_update_dpp(0, __float_as_uint(v), 0xB1, 0xF, 0xF, true));
    if (M == 2) return __uint_as_float(__builtin_amdgcn_update_dpp(0, __float_as_uint(v), 0x4E, 0xF, 0xF, true));
    return __uint_as_float(__builtin_amdgcn_ds_swizzle(__float_as_uint(v), (M << 10) | 0x1F));
}
__device__ __forceinline__ float xsum32_(float v) { auto rr = __builtin_amdgcn_permlane32_swap(__float_as_uint(v), __float_as_uint(v), false, false); return __uint_as_float(rr[0]) + __uint_as_float(rr[1]); }
__device__ __forceinline__ float xmax32_(float v) { auto rr = __builtin_amdgcn_permlane32_swap(__float_as_uint(v), __float_as_uint(v), false, false); return fmaxf(__uint_as_float(rr[0]), __uint_as_float(rr[1])); }
__device__ __forceinline__ float wave_sum(float v) { v += xshfl<1>(v); v += xshfl<2>(v); v += xshfl<4>(v); v += xshfl<8>(v); v += xshfl<16>(v); return xsum32_(v); }
__device__ __forceinline__ float wave_max(float v) { v = fmaxf(v, xshfl<1>(v)); v = fmaxf(v, xshfl<2>(v)); v = fmaxf(v, xshfl<4>(v)); v = fmaxf(v, xshfl<8>(v)); v = fmaxf(v, xshfl<16>(v)); return xmax32_(v); }
__device__ __forceinline__ int lane_id_now() { unsigned z = 0u; asm volatile("" : "+v"(z)); return (int)__builtin_amdgcn_mbcnt_hi(~0u, __builtin_amdgcn_mbcnt_lo(~0u, z)); }
__device__ __forceinline__ float sigmoidf_(float x) { return __builtin_amdgcn_rcpf(1.f + __expf(-x)); }
__device__ __forceinline__ float siluf_(float x) { return x * sigmoidf_(x); }
#define LDS_WAIT() asm volatile("s_waitcnt lgkmcnt(0)" ::: "memory")
#define VM_WAIT() asm volatile("s_waitcnt vmcnt(0)" ::: "memory")

__device__ __forceinline__ void publish_count(unsigned* cnt, bool leader) {
    asm volatile("s_waitcnt vmcnt(0)" ::: "memory"); __syncthreads();
    if (leader) (void)__hip_atomic_fetch_add(cnt, 1u, __ATOMIC_RELAXED, __HIP_MEMORY_SCOPE_AGENT);
}
__device__ __forceinline__ void wait_count(unsigned* cnt, unsigned expected, int wave) {
    if (wave == 0) { unsigned spins = 0;
        while ((unsigned)__builtin_amdgcn_readfirstlane((int)__hip_atomic_load(cnt, __ATOMIC_RELAXED, __HIP_MEMORY_SCOPE_AGENT)) < expected) { __builtin_amdgcn_s_sleep(2); if (++spins > (1u << 22)) break; }
        __builtin_amdgcn_fence(__ATOMIC_ACQUIRE, "agent"); asm volatile("s_waitcnt vmcnt(0)" ::: "memory"); }
    __syncthreads();
}
__device__ __forceinline__ void st_wt(float* p, float v) { __hip_atomic_store(p, v, __ATOMIC_RELAXED, __HIP_MEMORY_SCOPE_AGENT); }
__device__ __forceinline__ void st_wt(unsigned* p, unsigned v) { __hip_atomic_store(p, v, __ATOMIC_RELAXED, __HIP_MEMORY_SCOPE_AGENT); }

#define XB_TMO      128
#define XB_XCNT(j)  (256  + 64 * (j))
#define XB_XSUB(j)  (1280 + 64 * (j))
#define XB_XGEN(j)  (2304 + 64 * (j))
#define XB_TOP      3328
#define XB_TOPGEN   3392
#define XCD_BAR_WORDS 3456
#define XB_SPIN_CAP (1u << 18)
__device__ __forceinline__ unsigned xb_ld(unsigned* p)              { return __hip_atomic_load(p, __ATOMIC_RELAXED, __HIP_MEMORY_SCOPE_AGENT); }
__device__ __forceinline__ unsigned xb_add(unsigned* p, unsigned v) { return __hip_atomic_fetch_add(p, v, __ATOMIC_RELAXED, __HIP_MEMORY_SCOPE_AGENT); }
__device__ __forceinline__ unsigned xb_xcc_id() { return (unsigned)__builtin_amdgcn_s_getreg((3 << 11) | 20) & 0xFu; }
#define XB_SPIN(cond, bar) do { unsigned _sp = 0; while (cond) { __builtin_amdgcn_s_sleep(1); \
    if ((++_sp & 255u) == 0u) { if (xb_ld(&(bar)[XB_TMO])) break; if (_sp > XB_SPIN_CAP) { atomicAdd(&(bar)[XB_TMO], 1u); break; } } } } while (0)
struct XcdBarrier { unsigned* bar; unsigned x; volatile LAS unsigned* st; int wave; };
__device__ __forceinline__ XcdBarrier xcd_barrier_post(unsigned* bar, volatile LAS unsigned* st) {
    XcdBarrier b; b.bar = bar; b.x = xb_xcc_id(); b.st = st; b.wave = 0;
    if (threadIdx.x == 0) (void)xb_add(&bar[XB_XCNT(b.x)], 1u);
    return b;
}
__device__ __forceinline__ void xcd_barrier_complete(unsigned* bar, unsigned x, unsigned& nloc, unsigned& nx) {
    const unsigned G = gridDim.x * gridDim.y * gridDim.z;
    unsigned sum, cnt, mine, sp = 0u;
    for (;;) {
        sum = 0u; cnt = 0u; mine = 0u;
#pragma unroll
        for (unsigned j = 0; j < 16; ++j) { const unsigned c = xb_ld(&bar[XB_XCNT(j)]); sum += c; cnt += (c > 0u) ? 1u : 0u; mine = (j == x) ? c : mine; }
        if (sum == G) break;
        __builtin_amdgcn_s_sleep(1);
        if ((++sp & 255u) == 0u) { if (xb_ld(&bar[XB_TMO])) break; if (sp > XB_SPIN_CAP) { atomicAdd(&bar[XB_TMO], 1u); break; } }
    }
    nloc = mine > 0u ? mine : 1u; nx = cnt > 0u ? cnt : 1u;
}
__device__ __forceinline__ void xcd_barrier(const XcdBarrier& b) {
    asm volatile("s_waitcnt vmcnt(0)" ::: "memory");
    __syncthreads();
    if (b.wave == 0 && lane_id_now() == 0) {
        unsigned* bar = b.bar;
        __builtin_amdgcn_s_waitcnt(0);
        unsigned nloc = b.st[0], nx = b.st[1];
        if (nloc == 0u) { xcd_barrier_complete(bar, b.x, nloc, nx); b.st[0] = nloc; b.st[1] = nx; }
        const unsigned old = xb_add(&bar[XB_XSUB(b.x)], 1u);
        const unsigned gen = old / nloc;
        if (old + 1u == (gen + 1u) * nloc) {
            __builtin_amdgcn_fence(__ATOMIC_RELEASE, "agent");
            asm volatile("s_waitcnt vmcnt(0)" ::: "memory");
            const unsigned og = xb_add(&bar[XB_TOP], 1u);
            const unsigned tg = og / nx;
            if (og + 1u == (tg + 1u) * nx) xb_add(&bar[XB_TOPGEN], 1u);
            else XB_SPIN(xb_ld(&bar[XB_TOPGEN]) == tg, bar);
            __builtin_amdgcn_fence(__ATOMIC_ACQUIRE, "agent");
            xb_add(&bar[XB_XGEN(b.x)], 1u);
            asm volatile("s_waitcnt vmcnt(0)" ::: "memory");
        } else {
            XB_SPIN(xb_ld(&bar[XB_XGEN(b.x)]) == gen, bar);
            __builtin_amdgcn_fence(__ATOMIC_ACQUIRE, "agent");
            asm volatile("s_waitcnt vmcnt(0)" ::: "memory");
        }
    }
    __syncthreads();
}

namespace pg8 {
constexpr int BM = 256, BK = 64, HALF = 128, HTB = HALF * BK * 2, STAGE_BYTES = 8 * HTB, NXCD = 8;
__host__ __device__ __forceinline__ int lds_byte(int r, int c) { const int st = (r >> 4) * 2 + (c >> 5), rr = r & 15, cc = c & 31, ob = rr * 64 + cc * 2; return st * 1024 + (ob ^ (((ob >> 9) & 1) << 5)); }
__host__ __device__ __forceinline__ void stage_rc(int b, int& R, int& C) { const int st = b / 1024, sb = b % 1024, swz = sb ^ (((sb >> 9) & 1) << 5); R = (st >> 1) * 16 + swz / 64; C = (st & 1) * 32 + (swz % 64) / 2; }
__host__ __device__ __forceinline__ int perm32(int rho) { const int n = rho >> 4, i = rho & 15; return 8 * (i >> 2) + 4 * n + (i & 3); }

struct Unit { int pm, pn; const char* A; const char* B; int nt; int kind; };

template <int WGM, int nM, int nN> __device__ __forceinline__ void tile_of(int L, int& pm, int& pn) {
    const int nwg = nM * nN; int wgid = L;
    { const int q = nwg / NXCD, r = nwg % NXCD, xcd = wgid % NXCD, off = wgid / NXCD; wgid = (xcd < r ? xcd * (q + 1) : r * (q + 1) + (xcd - r) * q) + off; }
    const int nig = WGM * nN, gid = wgid / nig, fm = gid * WGM, gsz = (nM % WGM == 0) ? WGM : ((nM - fm) < WGM ? (nM - fm) : WGM);
    pm = fm + ((wgid % nig) % gsz); pn = (wgid % nig) / gsz;
}
template <int WGM_, int nM, int nN> struct PlainOrderT {
    const char* A; const char* Bt; int nt, G, c; size_t lda, ldb;
    __device__ __forceinline__ bool next(int i, Unit& u) const {
        const long L = (long)i * G + c; if (L >= (long)nM * nN) return false;
        tile_of<WGM_, nM, nN>((int)L, u.pm, u.pn);
        u.A = A + (size_t)u.pm * BM * lda * 2; u.B = Bt + (size_t)u.pn * BM * ldb * 2; u.nt = nt; u.kind = 0; return true;
    }
};
constexpr int WGM_POST = WGM_POST_V;
struct PostOrder {
    static constexpr int nM = MROWS / 256, nN = DM / 256; const char* XN; const char* Y; const char* Wcat; int G, c;
    __device__ __forceinline__ bool next(int ui, Unit& u) const {
        const int round = ui >> 3, sub = ui & 7, i = sub >> 1, kind = sub & 1;
        const long L = (long)round * G + c; if (L >= (long)nM * nN) return false;
        tile_of<WGM_POST, nM, nN>((int)L, u.pm, u.pn);
        const char* wb = Wcat + ((size_t)i * DM + (size_t)u.pn * BM) * KCAT * 2;
        if (kind == 0) { u.A = XN + (size_t)u.pm * BM * DM * 2; u.B = wb; u.nt = 16; }
        else           { u.A = Y + ((size_t)u.pm * BM * DM + 256 * i) * 2; u.B = wb + 1024 * 2; u.nt = 4; }
        u.kind = sub; return true;
    }
};

__device__ __forceinline__ float row_rstd(const float* ssq, int row) { const f32x4 q = *(const f32x4*)(ssq + (size_t)row * 4); return rsqrtf(((q.x + q.y) + (q.z + q.w)) * (1.f / DM) + 1e-6f); }
struct EpiP {
    static constexpr bool PERM = true; struct Carry {}; static __device__ __forceinline__ bool keeps_acc(int) { return false; }
    bf16* O; const float* ssq; const float* sw; LAS unsigned char* ept_;
    __device__ __forceinline__ void prefetch(const Unit& u, int wid, int ui) const {
        const int ln = lane_id_now(); LAS unsigned char* e = ept_ + (ui & 1) * 8192;
        if (wid < 4) __builtin_amdgcn_global_load_lds((const unsigned*)(ssq + ((size_t)u.pm * BM + wid * 64 + ln) * 4), (LAS unsigned*)(e + wid * 1024), 16, 0, 0);
        else if (wid == 4) __builtin_amdgcn_global_load_lds((const unsigned*)(sw + (size_t)(u.pm >> 5) * PW + u.pn * BM + ln * 4), (LAS unsigned*)(e + 4096), 16, 0, 0);
    }
    __device__ __forceinline__ void operator()(f32x4 (&acc)[2][2][4][2], const Unit& u, int wr, int wc, int fr, int fq, Carry&, int ui) const {
        asm volatile("" : "+v"(fr));
        const LAS unsigned char* ept = ept_ + (ui & 1) * 8192;
        const int row0 = u.pm * BM + wr * 64 + fr, col0 = u.pn * BM + wc * 32 + 8 * fq; const LAS float* swl = (const LAS float*)(ept + 4096) + wc * 32 + 8 * fq;
        const f32x4 s00 = *(const LAS f32x4*)(swl), s01 = *(const LAS f32x4*)(swl + 4), s10 = *(const LAS f32x4*)(swl + HALF), s11 = *(const LAS f32x4*)(swl + HALF + 4);
#pragma unroll
        for (int ai = 0; ai < 2; ++ai)
#pragma unroll
            for (int m = 0; m < 4; ++m) { const int row = row0 + ai * HALF + m * 16; const f32x4 q = *(const LAS f32x4*)(ept + (wr * 64 + fr + ai * HALF + m * 16) * 16);
                const float r = rsqrtf(((q.x + q.y) + (q.z + q.w)) * (1.f / DM) + 1e-6f); bf16* rowp = O + (size_t)row * PW + col0;
#pragma unroll
                for (int bj = 0; bj < 2; ++bj) { const f32x4 v0 = acc[ai][bj][m][0] * r + (bj ? s10 : s00), v1 = acc[ai][bj][m][1] * r + (bj ? s11 : s01);
                    u32x4 w; w.x = cvt_pk_bf16(v0[0], v0[1]); w.y = cvt_pk_bf16(v0[2], v0[3]); w.z = cvt_pk_bf16(v1[0], v1[1]); w.w = cvt_pk_bf16(v1[2], v1[3]);
                    *(u32x4*)(rowp + bj * HALF) = w; } }
    }
};
struct EpiPost {
    static constexpr bool PERM = true;
    static constexpr int NKR = 9, NKL = 3;
    struct Carry { u32x4 k[NKR]; };
    bf16* O; u32x4* scr; const float* ssq; const float* swm; LAS unsigned char* gl_; int tid_;
    static __device__ __forceinline__ bool keeps_acc(int kind) { return (kind & 1) == 0; }
    __device__ __forceinline__ void prefetch(const Unit& u, int wid, int) const {
        if (u.kind & 1) return;
        const int ln = lane_id_now(); LAS unsigned char* ept = gl_ + (L_EPT - L_GSLOT);
        if (wid < 4) __builtin_amdgcn_global_load_lds((const unsigned*)(ssq + ((size_t)u.pm * BM + wid * 64 + ln) * 4), (LAS unsigned*)(ept + wid * 1024), 16, 0, 0);
        else if (wid == 4) __builtin_amdgcn_global_load_lds((const unsigned*)(swm + (size_t)(u.pm >> 5) * 4096 + (u.kind >> 1) * DM + u.pn * BM + ln * 4), (LAS unsigned*)(ept + 4096), 16, 0, 0);
    }
    __device__ __forceinline__ void operator()(f32x4 (&acc)[2][2][4][2], const Unit& u, int wr, int wc, int fr, int fq, Carry& cy, int) const {
        int tid = ((wr * 4 + wc) << 6) | (fq << 4) | fr; const int i = u.kind >> 1;
        asm volatile("" : "+v"(tid), "+v"(fr));
        u32x4* sg = scr + ((tid >> 6) << 10) + (tid & 63);
        LAS u32x4* gl = (LAS u32x4*)(gl_ + tid * 16);
        const int row0 = u.pm * BM + wr * 64 + fr, col0 = u.pn * BM + wc * 32 + 8 * fq;
        u32x4 cin[16 - NKR];
        if ((u.kind & 1) == 0) {
            const LAS unsigned char* ept = gl_ + (L_EPT - L_GSLOT); const LAS float* swb = (const LAS float*)(ept + 4096) + wc * 32 + 8 * fq; const LAS float* sq = (const LAS float*)ept + (wr * 64 + fr) * 4;
            f32x4 q4[4];
#pragma unroll
            for (int k = 0; k < 4; ++k) q4[k] = *(const LAS f32x4*)(sq + k * 64);
            const f32x4 sw0a = *(const LAS f32x4*)(swb), sw0b = *(const LAS f32x4*)(swb + 4), sw1a = *(const LAS f32x4*)(swb + HALF), sw1b = *(const LAS f32x4*)(swb + HALF + 4);
            float rr[4];
#pragma unroll
            for (int sl = 0; sl < 16; ++sl) { const int ai = sl >> 3, bj = (sl >> 2) & 1, m = sl & 3;
                if (sl == 0 || sl == 8) {
#pragma unroll
                    for (int k = 0; k < 4; ++k) rr[k] = rsqrtf(((q4[k].x + q4[k].y) + (q4[k].z + q4[k].w)) * (1.f / DM) + 1e-6f); }
                if (sl == 2) {
#pragma unroll
                    for (int k = 0; k < 4; ++k) q4[k] = *(const LAS f32x4*)(sq + HALF * 4 + k * 64);
#pragma unroll
                    for (int s2 = NKR + NKL; s2 < 16; ++s2) cin[s2 - NKR] = sg[s2 * 64];
                    asm volatile("" ::: "memory"); }
                if (sl >= NKR && sl < NKR + NKL) cin[sl - NKR] = gl[(sl - NKR) * 512];
                const float r = rr[m];
                const f32x4 sa = bj ? sw1a : sw0a, sb = bj ? sw1b : sw0b; const f32x4 v0 = acc[ai][bj][m][0], v1 = acc[ai][bj][m][1];
                const u32x4 pin = (sl < NKR) ? cy.k[sl < NKR ? sl : 0] : cin[sl < NKR ? 0 : sl - NKR]; const u32x4 pq = (i > 0) ? pin : (u32x4){0u, 0u, 0u, 0u};
                float g[8];
                g[0] = fminf(1.f + __expf(-(v0[0] * r + sa[0])), 0x1p60f); g[1] = fminf(1.f + __expf(-(v0[1] * r + sa[1])), 0x1p60f); g[2] = fminf(1.f + __expf(-(v0[2] * r + sa[2])), 0x1p60f); g[3] = fminf(1.f + __expf(-(v0[3] * r + sa[3])), 0x1p60f);
                g[4] = fminf(1.f + __expf(-(v1[0] * r + sb[0])), 0x1p60f); g[5] = fminf(1.f + __expf(-(v1[1] * r + sb[1])), 0x1p60f); g[6] = fminf(1.f + __expf(-(v1[2] * r + sb[2])), 0x1p60f); g[7] = fminf(1.f + __expf(-(v1[3] * r + sb[3])), 0x1p60f);
                u32x4 w; w.x = cvt_pk_bf16(g[0], g[1]); w.y = cvt_pk_bf16(g[2], g[3]); w.z = cvt_pk_bf16(g[4], g[5]); w.w = cvt_pk_bf16(g[6], g[7]);
                f32x4 a0, a1;
                a0[0] = bflo(pq.x) * bflo(w.x); a0[1] = bfhi(pq.x) * bfhi(w.x); a0[2] = bflo(pq.y) * bflo(w.y); a0[3] = bfhi(pq.y) * bfhi(w.y);
                a1[0] = bflo(pq.z) * bflo(w.z); a1[1] = bfhi(pq.z) * bfhi(w.z); a1[2] = bflo(pq.w) * bflo(w.w); a1[3] = bfhi(pq.w) * bfhi(w.w);
                acc[ai][bj][m][0] = a0; acc[ai][bj][m][1] = a1;
                if (sl < NKR) cy.k[sl < NKR ? sl : 0] = w; else if (sl < NKR + NKL) gl[(sl - NKR) * 512] = w; else sg[sl * 64] = w; }
        } else {
            bf16* Ob = O + (size_t)row0 * DM + col0;
#pragma unroll
            for (int sl = NKR + NKL; sl < 16; ++sl) cin[sl - NKR] = sg[sl * 64];
#pragma unroll
            for (int sl = NKR; sl < NKR + NKL; ++sl) cin[sl - NKR] = gl[(sl - NKR) * 512];
#pragma unroll
            for (int sl = 0; sl < 16; ++sl) { const int ai = sl >> 3, bj = (sl >> 2) & 1, m = sl & 3; const f32x4 v0 = acc[ai][bj][m][0], v1 = acc[ai][bj][m][1];
                const u32x4 gq = (sl < NKR) ? cy.k[sl < NKR ? sl : 0] : cin[sl < NKR ? 0 : sl - NKR];
                u32x4 w; w.x = cvt_pk_bf16(v0[0] * __builtin_amdgcn_rcpf(bflo(gq.x)), v0[1] * __builtin_amdgcn_rcpf(bfhi(gq.x))); w.y = cvt_pk_bf16(v0[2] * __builtin_amdgcn_rcpf(bflo(gq.y)), v0[3] * __builtin_amdgcn_rcpf(bfhi(gq.y)));
                w.z = cvt_pk_bf16(v1[0] * __builtin_amdgcn_rcpf(bflo(gq.z)), v1[1] * __builtin_amdgcn_rcpf(bfhi(gq.z))); w.w = cvt_pk_bf16(v1[2] * __builtin_amdgcn_rcpf(bflo(gq.w)), v1[3] * __builtin_amdgcn_rcpf(bfhi(gq.w)));
                if (i == 3) *(u32x4*)(Ob + (ai * HALF + m * 16) * DM + bj * HALF) = w;
                else if (sl < NKR) cy.k[sl < NKR ? sl : 0] = w; else if (sl < NKR + NKL) gl[(sl - NKR) * 512] = w; else sg[sl * 64] = w; }
        }
    }
};
template <bool IN_BF, bool OUT_BF>
struct EpiOutT {
    static constexpr bool PERM = true; struct Carry {}; static __device__ __forceinline__ bool keeps_acc(int) { return false; } __device__ __forceinline__ void prefetch(const Unit&, int, int) const {}
    const float* xin; bf16* xb; bf16* xbo; const float* gate; bf16* xg; const float* gs; float* ssq; LAS float* tbl; int tid_;
    __device__ __forceinline__ void operator()(f32x4 (&acc)[2][2][4][2], const Unit& u, int wr, int wc, int fr, int fq, Carry&, int) const {
        const int b = u.pm >> 5; const float* gb = gate + (size_t)b * 3072;
        int tq = ((wr * 4 + wc) << 6) | (fq << 4) | fr; asm volatile("" : "+v"(fr), "+v"(fq), "+v"(tq));
        float ssl[2][4];
#pragma unroll
        for (int ai = 0; ai < 2; ++ai)
#pragma unroll
            for (int m = 0; m < 4; ++m) ssl[ai][m] = 0.f;
#pragma unroll
        for (int bj = 0; bj < 2; ++bj) {
            const int colb = u.pn * BM + bj * HALF + wc * 32 + 8 * fq; const f32x4 g0 = *(const f32x4*)(gb + colb), g1 = *(const f32x4*)(gb + colb + 4);
            f32x4 s0 = (f32x4){0.f, 0.f, 0.f, 0.f}, s1 = s0; if (gs) { s0 = *(const f32x4*)(gs + (size_t)b * DM + colb); s1 = *(const f32x4*)(gs + (size_t)b * DM + colb + 4); }
            u32x4 xw[2][4];
            if (IN_BF) {
#pragma unroll
                for (int ai = 0; ai < 2; ++ai)
#pragma unroll
                    for (int m = 0; m < 4; ++m) xw[ai][m] = *(const u32x4*)(xb + (size_t)(u.pm * BM + ai * HALF + wr * 64 + m * 16 + fr) * DM + colb);
            }
#pragma unroll
            for (int ai = 0; ai < 2; ++ai) {
                f32x4 xo[8];
                if (!IN_BF) {
#pragma unroll
                    for (int q = 0; q < 8; ++q) { const int n = q & 1, m = q >> 1; xo[q] = *(const f32x4*)(xin + (size_t)(u.pm * BM + ai * HALF + wr * 64 + m * 16 + fr) * DM + colb + 4 * n); }
                }
#pragma unroll
                for (int m = 0; m < 4; ++m) { const size_t off = (size_t)(u.pm * BM + ai * HALF + wr * 64 + m * 16 + fr) * DM + colb;
                    f32x4 oa, ob;
                    if (IN_BF) { const u32x4 w = xw[ai][m]; oa = (f32x4){bflo(w.x), bfhi(w.x), bflo(w.y), bfhi(w.y)}; ob = (f32x4){bflo(w.z), bfhi(w.z), bflo(w.w), bfhi(w.w)}; }
                    else { oa = xo[2 * m]; ob = xo[2 * m + 1]; }
                    const f32x4 xa = oa + g0 * acc[ai][bj][m][0], xb_ = ob + g1 * acc[ai][bj][m][1];
                    { u32x4 w; w.x = cvt_pk_bf16(xa.x, xa.y); w.y = cvt_pk_bf16(xa.z, xa.w); w.z = cvt_pk_bf16(xb_.x, xb_.y); w.w = cvt_pk_bf16(xb_.z, xb_.w); *(u32x4*)(xbo + off) = w; }
                    ssl[ai][m] += ((xa.x * xa.x + xa.y * xa.y) + (xa.z * xa.z + xa.w * xa.w)) + ((xb_.x * xb_.x + xb_.y * xb_.y) + (xb_.z * xb_.z + xb_.w * xb_.w));
                    if (gs) { const f32x4 ha = xa * s0, hb = xb_ * s1; u32x4 w; w.x = cvt_pk_bf16(ha.x, ha.y); w.y = cvt_pk_bf16(ha.z, ha.w); w.z = cvt_pk_bf16(hb.x, hb.y); w.w = cvt_pk_bf16(hb.z, hb.w); *(u32x4*)(xg + off) = w; } }
                if (!IN_BF) asm volatile("" ::: "memory");
            }
            asm volatile("" ::: "memory");
        }
#pragma unroll
        for (int ai = 0; ai < 2; ++ai)
#pragma unroll
            for (int m = 0; m < 4; ++m) { float v = ssl[ai][m]; v += xshfl<16>(v); v = xsum32_(v); if (fq == 0) tbl[(ai * HALF + wr * 64 + m * 16 + fr) * 4 + wc] = v; }
        asm volatile("s_waitcnt lgkmcnt(0)" ::: "memory"); __builtin_amdgcn_s_barrier(); asm volatile("" ::: "memory");
        { const int t = tq; if (t < 256) { const f32x4 q = *(const LAS f32x4*)(tbl + t * 4); ssq[(size_t)(u.pm * BM + t) * 4 + u.pn] = (q.x + q.y) + (q.z + q.w); } }
    }
};

struct EpiNull {
    static constexpr bool PERM = true; struct Carry {}; static __device__ __forceinline__ bool keeps_acc(int) { return false; } __device__ __forceinline__ void prefetch(const Unit&, int, int) const {} float* sink;
    __device__ __forceinline__ void operator()(f32x4 (&acc)[2][2][4][2], const Unit& u, int wr, int wc, int fr, int fq, Carry&, int) const {
        f32x4 s = (f32x4){0.f, 0.f, 0.f, 0.f};
#pragma unroll
        for (int a = 0; a < 2; ++a)
#pragma unroll
            for (int b = 0; b < 2; ++b)
#pragma unroll
                for (int m = 0; m < 4; ++m)
#pragma unroll
                    for (int n = 0; n < 2; ++n) s += acc[a][b][m][n];
        if ((s.x + s.y) + (s.z + s.w) == 1.2345e38f) sink[0] = s.x;
    }
};

template <class Epi, class Sched, bool ALIGN_EPI>
__device__ __forceinline__ void gemm_phase(LAS unsigned char* lds, const int lda, const int ldb, const Sched& S, const Epi& E, int tid) {
    asm volatile("" : "+v"(tid));
    const int wid = __builtin_amdgcn_readfirstlane(tid >> 6), lane = tid & 63, wr = wid >> 2, wc = wid & 3, fr = lane & 15, fq = lane >> 4;
    unsigned voffA[2], voffB[2];
#pragma unroll
    for (int i = 0; i < 2; ++i) { int R, C; stage_rc(tid * 16 + i * 8192, R, C); const int Rb = Epi::PERM ? ((R & ~31) + perm32(R & 31)) : R;
        voffA[i] = (unsigned)(R * lda + C) * 2u; voffB[i] = (unsigned)(Rb * ldb + C) * 2u; }
    const size_t kstep = (size_t)(BK * 2);
    const size_t hstepA = (size_t)HALF * lda * 2, hstepB = (size_t)HALF * ldb * 2;
    const unsigned ldsw = (unsigned)wid * 1024u;
    const int aoff = lds_byte(wr * 64 + fr, fq * 8), boff = lds_byte(wc * 32 + fr, fq * 8);
#define PG8_SA(b, h) (((b) * 2 + (h)) * HTB)
#define PG8_SB(b, h) ((4 + (b) * 2 + (h)) * HTB)
#define PG8_STAGE(bufoff, gbase, voff) do { _Pragma("unroll") for (int _i = 0; _i < 2; ++_i) { unsigned vo_ = (voff)[_i]; asm volatile("" : "+v"(vo_));     \
        __builtin_amdgcn_global_load_lds((const unsigned*)((const char*)(gbase) + vo_), (LAS unsigned*)(lds + (bufoff) + ldsw + _i * 8192), 16, 0, 0); } } while (0)
#define PG8_LDA(dst, b, h) do { _Pragma("unroll") for (int m = 0; m < 4; ++m) _Pragma("unroll") for (int k = 0; k < 2; ++k) dst[m][k] = *(const LAS bf16x8*)(lds + PG8_SA(b, h) + aoff + m * 2048 + k * 1024); } while (0)
#define PG8_LDB(dst, b, h) do { _Pragma("unroll") for (int n = 0; n < 2; ++n) _Pragma("unroll") for (int k = 0; k < 2; ++k) dst[n][k] = *(const LAS bf16x8*)(lds + PG8_SB(b, h) + boff + n * 2048 + k * 1024); } while (0)
#define PG8_MMA(ai, bj, At, Bt) do { __builtin_amdgcn_s_setprio(1); _Pragma("unroll") for (int m = 0; m < 4; ++m) _Pragma("unroll") for (int n = 0; n < 2; ++n) _Pragma("unroll") for (int k = 0; k < 2; ++k) \
        acc[ai][bj][m][n] = __builtin_amdgcn_mfma_f32_16x16x32_bf16(Bt[n][k], At[m][k], acc[ai][bj][m][n], 0, 0, 0); __builtin_amdgcn_s_setprio(0); } while (0)
#define PG8_WAIT_V(n) asm volatile("s_waitcnt vmcnt(" #n ")" ::: "memory")
#define PG8_WAIT_L(n) asm volatile("s_waitcnt lgkmcnt(" #n ")" ::: "memory")
#define PG8_BAR __builtin_amdgcn_s_barrier()
#define PG8_SCHED __builtin_amdgcn_sched_barrier(0)
    Unit cur, nxt; int ui = 0;
    if (!S.next(0, cur)) return;
    typename Epi::Carry carry;
    f32x4 acc[2][2][4][2];
#pragma unroll
    for (int a = 0; a < 2; ++a)
#pragma unroll
        for (int b = 0; b < 2; ++b)
#pragma unroll
            for (int m = 0; m < 4; ++m)
#pragma unroll
                for (int n = 0; n < 2; ++n) acc[a][b][m][n] = (f32x4){0.f, 0.f, 0.f, 0.f};
    bf16x8 At[4][2], B0[2][2], B1[2][2];
    const char* cA = cur.A; const char* cB = cur.B;
    PG8_STAGE(PG8_SB(0, 0), cB, voffB); PG8_STAGE(PG8_SB(0, 1), cB + hstepB, voffB); PG8_STAGE(PG8_SA(0, 0), cA, voffA); PG8_STAGE(PG8_SA(0, 1), cA + hstepA, voffA);
    if (wr == 1) PG8_BAR;
    PG8_WAIT_V(2); PG8_BAR;
    PG8_STAGE(PG8_SB(1, 0), cB + kstep, voffB); PG8_STAGE(PG8_SA(1, 0), cA + kstep, voffA); PG8_STAGE(PG8_SB(1, 1), cB + hstepB + kstep, voffB);
    PG8_WAIT_V(6); PG8_BAR;
    for (;;) {
        const bool has_next = S.next(ui + 1, nxt);
        const char* nA = has_next ? nxt.A : cA; const char* nB = has_next ? nxt.B : cB;
        const int nt = cur.nt;
        E.prefetch(cur, wid, ui);
        for (int t = 0; t < nt; t += 2) {
            const bool last = (t == nt - 2);
            const char* a1 = cA + (size_t)(t + 1) * kstep;
            const char* a2 = last ? nA : cA + (size_t)(t + 2) * kstep; const char* b2 = last ? nB : cB + (size_t)(t + 2) * kstep;
            const char* a3 = a2 + kstep; const char* b3 = b2 + kstep;
            PG8_LDB(B0, 0, 0); PG8_LDB(B1, 0, 1); PG8_SCHED; PG8_LDA(At, 0, 0); PG8_STAGE(PG8_SA(1, 1), a1 + hstepA, voffA);
            PG8_WAIT_V(8); PG8_WAIT_L(0); PG8_BAR; PG8_MMA(0, 0, At, B0); PG8_MMA(0, 1, At, B1); PG8_BAR; PG8_SCHED;
            PG8_LDA(At, 0, 1); PG8_STAGE(PG8_SB(0, 0), b2, voffB); PG8_STAGE(PG8_SB(0, 1), b2 + hstepB, voffB); PG8_STAGE(PG8_SA(0, 0), a2, voffA);
            PG8_WAIT_V(8); PG8_WAIT_L(0); PG8_BAR; PG8_MMA(1, 0, At, B0); PG8_MMA(1, 1, At, B1); PG8_BAR; PG8_SCHED;
            PG8_LDB(B0, 1, 0); PG8_LDB(B1, 1, 1); PG8_SCHED; PG8_LDA(At, 1, 0); PG8_STAGE(PG8_SA(0, 1), a2 + hstepA, voffA);
            PG8_WAIT_V(8); PG8_WAIT_L(0); PG8_BAR; PG8_MMA(0, 0, At, B0); PG8_MMA(0, 1, At, B1); PG8_BAR; PG8_SCHED;
            PG8_LDA(At, 1, 1); PG8_STAGE(PG8_SB(1, 0), b3, voffB); PG8_STAGE(PG8_SB(1, 1), b3 + hstepB, voffB); PG8_STAGE(PG8_SA(1, 0), a3, voffA);
            PG8_WAIT_V(8); PG8_WAIT_L(0); PG8_BAR; PG8_MMA(1, 0, At, B0); PG8_MMA(1, 1, At, B1); PG8_BAR; PG8_SCHED;
        }
        if constexpr (ALIGN_EPI) { if (wr == 0) PG8_BAR; }
        { const int ln = lane_id_now(); E(acc, cur, wr, wc, ln & 15, ln >> 4, carry, ui); }
        if (!has_next) break;
        if (!Epi::keeps_acc(cur.kind)) {
#pragma unroll
        for (int a = 0; a < 2; ++a)
#pragma unroll
            for (int b = 0; b < 2; ++b)
#pragma unroll
                for (int m = 0; m < 4; ++m)
#pragma unroll
                    for (int n = 0; n < 2; ++n) acc[a][b][m][n] = (f32x4){0.f, 0.f, 0.f, 0.f};
        }
        cur = nxt; cA = nA; cB = nB; ++ui;
        if constexpr (ALIGN_EPI) { if (wr == 1) PG8_BAR; }
    }
    PG8_WAIT_V(0);
    if constexpr (!ALIGN_EPI) { if (wr == 0) PG8_BAR; }
    PG8_BAR;
#undef PG8_SA
#undef PG8_SB
#undef PG8_STAGE
#undef PG8_LDA
#undef PG8_LDB
#undef PG8_MMA
#undef PG8_WAIT_V
#undef PG8_WAIT_L
#undef PG8_BAR
#undef PG8_SCHED
}
}

struct Args {
    const float* x; const float* c; const float* w_ada; const float* b_ada; const float* norm_g; const float* w_in; const float* cmp_pos; const float* cmp_w1; const float* cmp_w2;
    const float* sink; const float* w_merge; const float* w_br; const float* w_out; const float* final_g;
    float* out; unsigned char* ws; int ph_lo, ph_hi, li, pad;
};

__device__ __forceinline__ int win_src_col(int n) { return n < 640 ? n : (n < 3712 ? n + 12 : (n < 3724 ? n - 3072 : -1)); }
template <bool WINMAP>
__device__ __forceinline__ void transpose_item(const float* W, int spitch, bf16* WT, int dpitch, int dkoff, LAS float* scr, int kb, int nb, int lane) {
    const int k0 = 64 * kb, n0 = 32 * nb;
    int sc = n0 + (lane & 31); if (WINMAP) sc = win_src_col(sc);
    float wv[32];
#pragma unroll
    for (int i = 0; i < 32; ++i) { const int kk = 2 * i + (lane >> 5); wv[i] = sc >= 0 ? W[(size_t)(k0 + kk) * spitch + sc] : 0.f; }
#pragma unroll
    for (int i = 0; i < 32; ++i) { const int kk = 2 * i + (lane >> 5); scr[kk * 33 + (lane & 31)] = wv[i]; }
    LDS_WAIT(); asm volatile("" ::: "memory");
    const int c = lane & 7;
#pragma unroll
    for (int j = 0; j < 4; ++j) { const int n = (lane >> 3) + 8 * j; const LAS float* s = scr + (8 * c) * 33 + n;
        u32x4 o; o.x = pk2(s[0 * 33], s[1 * 33]); o.y = pk2(s[2 * 33], s[3 * 33]); o.z = pk2(s[4 * 33], s[5 * 33]); o.w = pk2(s[6 * 33], s[7 * 33]);
        *(u32x4*)(WT + (size_t)(n0 + n) * dpitch + dkoff + k0 + 8 * c) = o; }
    LDS_WAIT(); asm volatile("" ::: "memory");
}

namespace fa {
typedef float f32x16 __attribute__((ext_vector_type(16)));
typedef short s16x4 __attribute__((ext_vector_type(4)));
typedef short v4i16_t __attribute__((ext_vector_type(4)));
constexpr int SLOT = 16384, L_STG = 65536, L_SEL = 132096, L_UNI = L_SEL + 1024, L_WSF = L_UNI + 64, L_FLG = L_WSF + 2048;
constexpr float LOG2E = 1.4426950408889634f;
__device__ __forceinline__ int crow(int r, int hi) { return (r & 3) + 8 * (r >> 2) + 4 * hi; }
__device__ __forceinline__ float xmax32(float v) { auto rr = __builtin_amdgcn_permlane32_swap(__float_as_uint(v), __float_as_uint(v), false, false); return fmaxf(__uint_as_float(rr[0]), __uint_as_float(rr[1])); }
__device__ __forceinline__ float xsum32(float v) { auto rr = __builtin_amdgcn_permlane32_swap(__float_as_uint(v), __float_as_uint(v), false, false); return __uint_as_float(rr[0]) + __uint_as_float(rr[1]); }
__device__ __forceinline__ void dma_tile(const bf16* k0, const bf16* v0, size_t pitch, LAS unsigned char* slot, int wid, int lane) {
    __builtin_amdgcn_global_load_lds((const unsigned*)(k0 + (size_t)lane * pitch + wid * 8), (LAS unsigned*)(slot + wid * 1024), 16, 0, 0);
    __builtin_amdgcn_global_load_lds((const unsigned*)(v0 + (size_t)(16 * (wid & 3) + (lane >> 2)) * pitch + (wid >> 2) * 32 + (lane & 3) * 8), (LAS unsigned*)(slot + 8192 + wid * 1024), 16, 0, 0);
}
#define FA_WAIT(n) asm volatile("s_waitcnt vmcnt(" #n ") lgkmcnt(0)" ::: "memory")
#define FA_BAR() do { __builtin_amdgcn_s_barrier(); asm volatile("" ::: "memory"); } while (0)
template <class Next, class Issue, class Compute, class Prelude>
__device__ __forceinline__ void tile_stream(int first, Next next, Issue issue, Compute compute, Prelude prelude);
template <class Next, class Issue, class Compute>
__device__ __forceinline__ void tile_stream(int first, Next next, Issue issue, Compute compute) { tile_stream(first, next, issue, compute, []() {}); }
template <class Next, class Issue, class Compute, class Prelude>
__device__ __forceinline__ void tile_stream(int first, Next next, Issue issue, Compute compute, Prelude prelude) {
    int t0 = first, t1 = t0 >= 0 ? next(t0) : -1, t2 = t1 >= 0 ? next(t1) : -1, t3 = t2 >= 0 ? next(t2) : -1, slot = 0;
    if (t0 >= 0) issue(t0, 0);
    if (t1 >= 0) issue(t1, 1);
    if (t2 >= 0) issue(t2, 2);
    prelude();
    while (t0 >= 0) {
        if (t2 >= 0) FA_WAIT(4); else if (t1 >= 0) FA_WAIT(2); else FA_WAIT(0);
        FA_BAR();
        if (t3 >= 0) issue(t3, (slot + 3) & 3);
        compute(t0, slot);
        t0 = t1; t1 = t2; t2 = t3; t3 = t2 >= 0 ? next(t2) : -1; slot = (slot + 1) & 3;
    }
    FA_BAR();
}
__device__ __forceinline__ void qkt(f32x16& p0, f32x16& p1, const LAS unsigned char* kt, const bf16x8 (&qr)[4], int r32, int hi) {
    const LAS unsigned char* kb = kt + hi * 1024 + r32 * 16;
    p0 = (f32x16){0.f, 0.f, 0.f, 0.f, 0.f, 0.f, 0.f, 0.f, 0.f, 0.f, 0.f, 0.f, 0.f, 0.f, 0.f, 0.f}; p1 = p0;
#pragma unroll
    for (int d0 = 0; d0 < 4; ++d0) { const bf16x8 b0 = *(const LAS bf16x8*)(kb + d0 * 2048), b1 = *(const LAS bf16x8*)(kb + d0 * 2048 + 512);
        p0 = __builtin_amdgcn_mfma_f32_32x32x16_bf16(b0, qr[d0], p0, 0, 0, 0); p1 = __builtin_amdgcn_mfma_f32_32x32x16_bf16(b1, qr[d0], p1, 0, 0, 0); }
}
__device__ __forceinline__ s16x4 vtr(const LAS unsigned char* p) { return __builtin_bit_cast(s16x4, __builtin_amdgcn_ds_read_tr16_b64_v4i16((LAS v4i16_t*)p)); }
__device__ __forceinline__ void pv(f32x16 (&o)[2], const LAS unsigned char* vt, const u32x4 (&pw)[4], int lane) {
    const LAS unsigned char* vp = vt + ((lane >> 4) & 1) * 32 + (lane & 3) * 8 + (4 * (lane >> 5) + ((lane & 15) >> 2)) * 64;
#pragma unroll
    for (int d0 = 0; d0 < 2; ++d0)
#pragma unroll
        for (int ks = 0; ks < 4; ++ks) { const s16x4 lo = vtr(vp + d0 * 4096 + ks * 1024), hi4 = vtr(vp + d0 * 4096 + ks * 1024 + 512);
            const bf16x8 vf = (bf16x8){lo[0], lo[1], lo[2], lo[3], hi4[0], hi4[1], hi4[2], hi4[3]};
            o[d0] = __builtin_amdgcn_mfma_f32_32x32x16_bf16(__builtin_bit_cast(bf16x8, pw[ks]), vf, o[d0], 0, 0, 0); }
}
__device__ __forceinline__ void pack_p(u32x4 (&pw)[4], const f32x16& p0, const f32x16& p1) {
    pw[0] = (u32x4){cvt_pk_bf16(p0[0], p0[1]), cvt_pk_bf16(p0[2], p0[3]), cvt_pk_bf16(p0[4], p0[5]), cvt_pk_bf16(p0[6], p0[7])};
    pw[1] = (u32x4){cvt_pk_bf16(p0[8], p0[9]), cvt_pk_bf16(p0[10], p0[11]), cvt_pk_bf16(p0[12], p0[13]), cvt_pk_bf16(p0[14], p0[15])};
    pw[2] = (u32x4){cvt_pk_bf16(p1[0], p1[1]), cvt_pk_bf16(p1[2], p1[3]), cvt_pk_bf16(p1[4], p1[5]), cvt_pk_bf16(p1[6], p1[7])};
    pw[3] = (u32x4){cvt_pk_bf16(p1[8], p1[9]), cvt_pk_bf16(p1[10], p1[11]), cvt_pk_bf16(p1[12], p1[13]), cvt_pk_bf16(p1[14], p1[15])};
}
__device__ __forceinline__ void scale_rows(f32x16 (&o)[2], float f, LAS float* wsf, int r32, int hi) {
    if (hi == 0) wsf[r32] = f;
#pragma unroll
    for (int r = 0; r < 16; ++r) { const float fr = wsf[crow(r, hi)]; o[0][r] *= fr; o[1][r] *= fr; }
}
__device__ __forceinline__ void stage_o(const f32x16 (&o)[2], LAS float* stg, int r32, int hi) {
#pragma unroll
    for (int r = 0; r < 16; ++r) { const int orow = crow(r, hi); stg[orow * 64 + r32] = o[0][r]; stg[orow * 64 + 32 + r32] = o[1][r]; }
}
__device__ __forceinline__ void load_z(u32x4 (&z)[4], const bf16* P, size_t m0, int zcol, int h, int lane) {
#pragma unroll
    for (int i = 0; i < 4; ++i) z[i] = *(const u32x4*)(P + (m0 + i * 8 + (lane >> 3)) * PW + zcol + h * 64 + (lane & 7) * 8);
}
__device__ __forceinline__ void emit_y(const LAS float* stg, const u32x4 (&zz)[4], bf16* Y, size_t m0, int ycol, int h, int lane) {
#pragma unroll
    for (int i = 0; i < 4; ++i) { const int row = i * 8 + (lane >> 3), ch = lane & 7;
        const f32x4 a = *(const LAS f32x4*)(stg + row * 64 + ch * 8), c = *(const LAS f32x4*)(stg + row * 64 + ch * 8 + 4);
        const u32x4 z = zz[i];
        u32x4 w; w.x = cvt_pk_bf16(a.x * siluf_(bflo(z.x)), a.y * siluf_(bfhi(z.x))); w.y = cvt_pk_bf16(a.z * siluf_(bflo(z.y)), a.w * siluf_(bfhi(z.y)));
        w.z = cvt_pk_bf16(c.x * siluf_(bflo(z.z)), c.y * siluf_(bfhi(z.z))); w.w = cvt_pk_bf16(c.z * siluf_(bflo(z.w)), c.w * siluf_(bfhi(z.w)));
        *(u32x4*)(Y + (m0 + row) * DM + ycol + h * 64 + ch * 8) = w; }
}
__device__ __forceinline__ void softmax_step(f32x16& p0, f32x16& p1, float& m, float& l, f32x16 (&o)[2], LAS float* wsf, int r32, int hi) {
    float rm = fmaxf(p0[0], p1[0]);
#pragma unroll
    for (int r = 1; r < 16; ++r) rm = fmaxf(rm, fmaxf(p0[r], p1[r]));
    rm = xmax32(rm);
    const float mn = fmaxf(m, rm), f = __builtin_amdgcn_exp2f(m - mn); m = mn;
    float rs = 0.f;
#pragma unroll
    for (int r = 0; r < 16; ++r) { p0[r] = (p0[r] > -1e29f) ? __builtin_amdgcn_exp2f(p0[r] - mn) : 0.f; p1[r] = (p1[r] > -1e29f) ? __builtin_amdgcn_exp2f(p1[r] - mn) : 0.f; rs += p0[r] + p1[r]; }
    l = l * f + xsum32(rs);
    if (__any(f != 1.f)) scale_rows(o, f, wsf, r32, hi);
}

constexpr int L_DUMMY = L_FLG + 1024;
enum { K_NONE = 0, K_SWA = 1, K_STICK = 2, K_NSA = 3, K_RET = 4, K_NSA_TOUCH = 5 };
struct NextUnit { int kind, unit; bool with_r; };
struct PreCtx { const bf16* P; const bf16* KCB; const bf16* VCB; const float* R; };
__device__ __forceinline__ void touch_line(const void* p, LAS unsigned char* lds, int wid) { __builtin_amdgcn_global_load_lds((const unsigned*)p, (LAS unsigned*)(lds + L_DUMMY + wid * 256), 4, 0, 0); }
__device__ __forceinline__ void swa_first(const bf16* P, int unit, LAS unsigned char* lds, int wid, int lane, bool touch) {
    const int b = unit >> 7, kvh = (unit >> 6) & 1, pos0 = (unit & 63) * 128; const bf16* Pb = P + (size_t)b * SEQ * PW;
    const int jlo = (pos0 >= 127 ? pos0 - 127 : 0) >> 6, jhi = (pos0 + 127) >> 6;
    const bf16* kb = Pb + B_K + kvh * 64; const bf16* vb = Pb + B_V + kvh * 64;
    for (int j = jlo; j <= jhi; ++j) dma_tile(kb + (size_t)(64 * j) * PW, vb + (size_t)(64 * j) * PW, PW, lds + (j - jlo) * SLOT, wid, lane);
    if (touch) { const int idx = wid * 64 + lane, row = idx >> 2, li = idx & 3;
        touch_line((const char*)(Pb + (size_t)(pos0 + row) * PW) + ((li < 2 ? B_Q : B_Z) * 2 + kvh * 256 + (li & 1) * 128), lds, wid); }
}
__device__ __forceinline__ void stick_first(const bf16* P, int unit, LAS unsigned char* lds, int wid, int lane, bool touch) {
    const int b = unit >> 7, h0 = 2 * ((unit >> 6) & 1), pos0 = (unit & 63) * 128, jtop = (pos0 + 126) >> 6; const bf16* Pb = P + (size_t)b * SEQ * PW;
    const bf16* kb = Pb + C_K + h0 * 64; const bf16* vb = Pb + C_V + h0 * 64;
    dma_tile(kb + (size_t)(64 * jtop) * PW, vb + (size_t)(64 * jtop) * PW, PW, lds, wid, lane);
    dma_tile(kb + 64 + (size_t)(64 * jtop) * PW, vb + 64 + (size_t)(64 * jtop) * PW, PW, lds + SLOT, wid, lane);
    if (touch) { const int idx = wid * 64 + lane, row = idx >> 2, li = idx & 3;
        touch_line((const char*)(Pb + (size_t)(pos0 + row) * PW) + ((li < 2 ? C_Q : C_Z) * 2 + h0 * 128 + (li & 1) * 128), lds, wid); }
}
__device__ __forceinline__ void nsa_first(const bf16* P, const bf16* KCB, const bf16* VCB, int unit, LAS unsigned char* lds, int wid, int lane, bool touch, bool tiles) {
    const int b = unit >> 7, pos0 = ((b & 2) ? 127 - (unit & 127) : (unit & 127)) * 64, ncvmax = (pos0 >> 5) + 2, ntile = tiles ? (ncvmax + 63) >> 6 : 0;
    for (int tl = 0; tl < ntile; ++tl) {
        __builtin_amdgcn_global_load_lds((const unsigned*)(KCB + ((size_t)b * 256 + 64 * tl + lane) * 64 + wid * 8), (LAS unsigned*)(lds + tl * 8192 + wid * 1024), 16, 0, 0);
        __builtin_amdgcn_global_load_lds((const unsigned*)(VCB + ((size_t)b * 256 + 64 * tl + 16 * (wid & 3) + (lane >> 2)) * 64 + (wid >> 2) * 32 + (lane & 3) * 8), (LAS unsigned*)(lds + 32768 + tl * 8192 + wid * 1024), 16, 0, 0); }
    if (touch) { const bf16* Pb = P + (size_t)b * SEQ * PW; const int idx = wid * 64 + lane, row = idx >> 3, li = idx & 7;
        touch_line((const char*)(Pb + (size_t)(pos0 + row) * PW) + ((li < 4 ? A_Q : A_Z) * 2 + (li & 3) * 128), lds, wid);
        if (wid == 0) touch_line((const char*)(Pb + (size_t)(pos0 + lane) * PW) + A_G * 2, lds, wid); }
}
__device__ __forceinline__ void ret_first(const bf16* P, const float* R, int unit, LAS unsigned char* lds, int wid, int lane, bool touch, bool with_r) {
    const int b = unit >> 7, h = (unit >> 5) & 3, pos0 = (unit & 31) * 256, j0 = pos0 >> 6; const bf16* Pb = P + (size_t)b * SEQ * PW;
    const bf16* kb = Pb + D_K + h * 64; const bf16* vb = Pb + D_V + h * 64;
#pragma unroll
    for (int tt = 0; tt < 4; ++tt) dma_tile(kb + (size_t)(64 * (j0 + tt)) * PW, vb + (size_t)(64 * (j0 + tt)) * PW, PW, lds + (2 * (tt & 1) + (tt >> 1)) * SLOT, wid, lane);
    if (touch) { const int idx = wid * 64 + lane, row = idx >> 1, li = idx & 1;
        touch_line((const char*)(Pb + (size_t)(pos0 + row) * PW) + ((li ? D_Z : D_Q) * 2 + h * 128), lds, wid);
        if (with_r && wid < 4) { const int n = (pos0 >> 7) + (idx >> 7); touch_line((const char*)(R + ((((size_t)b * 64 + n) * 4 + h) * 64) * 64) + (idx & 127) * 128, lds, wid); } }
}
__device__ __forceinline__ void issue_first(const NextUnit& nx, const PreCtx& pc, LAS unsigned char* lds, int wid, int lane) {
    if (nx.kind == K_SWA) swa_first(pc.P, nx.unit, lds, wid, lane, true);
    else if (nx.kind == K_STICK) stick_first(pc.P, nx.unit, lds, wid, lane, true);
    else if (nx.kind == K_NSA) nsa_first(pc.P, pc.KCB, pc.VCB, nx.unit, lds, wid, lane, true, true);
    else if (nx.kind == K_NSA_TOUCH) nsa_first(pc.P, pc.KCB, pc.VCB, nx.unit, lds, wid, lane, true, false);
    else if (nx.kind == K_RET) ret_first(pc.P, pc.R, nx.unit, lds, wid, lane, true, nx.with_r);
}
__device__ __forceinline__ void swa_unit(const bf16* P, const float* sink4, bf16* Y, int unit, LAS unsigned char* lds, int tid, bool pre, const NextUnit& nx, const PreCtx& pc) {
    asm volatile("" : "+v"(tid));
    const int lane = tid & 63, wid = __builtin_amdgcn_readfirstlane(tid >> 6), r32 = lane & 31, hi = lane >> 5;
    const int b = unit >> 7, kvh = (unit >> 6) & 1, pos0 = (unit & 63) * 128, h = 2 * kvh + (wid & 1), tw0 = pos0 + 32 * (wid >> 1), t = tw0 + r32;
    const bf16* Pb = P + (size_t)b * SEQ * PW;
    bf16x8 qr[4];
#pragma unroll
    for (int d0 = 0; d0 < 4; ++d0) qr[d0] = *(const bf16x8*)(Pb + (size_t)t * PW + B_Q + h * 64 + d0 * 16 + hi * 8);
    const float slope2 = exp2f(-2.f * (float)(h + 1)) * LOG2E, scale2 = 0.125f * LOG2E;
    u32x4 zz[4]; load_z(zz, P, (size_t)b * SEQ + tw0, B_Z, h, lane);
    float m = sink4[h] * LOG2E, l = 1.f; f32x16 o[2];
#pragma unroll
    for (int r = 0; r < 16; ++r) { o[0][r] = 0.f; o[1][r] = 0.f; }
    LAS float* wsf = (LAS float*)(lds + L_WSF) + wid * 64; LAS float* stg = (LAS float*)(lds + L_STG) + wid * 2048;
    const int jlo = (pos0 >= 127 ? pos0 - 127 : 0) >> 6, jhi = (pos0 + 127) >> 6;
    const bf16* kb = Pb + B_K + kvh * 64; const bf16* vb = Pb + B_V + kvh * 64;
    if (!pre) for (int j = jlo; j <= jhi; ++j) dma_tile(kb + (size_t)(64 * j) * PW, vb + (size_t)(64 * j) * PW, PW, lds + (j - jlo) * SLOT, wid, lane);
    FA_WAIT(0); FA_BAR();
    for (int j = jlo; j <= jhi; ++j) {
        if (64 * j + 63 >= tw0 - 127 && 64 * j <= tw0 + 31) {
            const LAS unsigned char* kt = lds + (j - jlo) * SLOT;
            f32x16 p0, p1; qkt(p0, p1, kt, qr, r32, hi);
            const int d0 = t - (64 * j + 4 * hi);
#pragma unroll
            for (int r = 0; r < 16; ++r) { const int d = d0 - ((r & 3) + 8 * (r >> 2)), e = d - 32;
                p0[r] = (d >= 0 && d < 128) ? p0[r] * scale2 - slope2 * (float)d : -1e30f; p1[r] = (e >= 0 && e < 128) ? p1[r] * scale2 - slope2 * (float)e : -1e30f; }
            softmax_step(p0, p1, m, l, o, wsf, r32, hi);
            u32x4 pw[4]; pack_p(pw, p0, p1); pv(o, kt + 8192, pw, lane);
        }
    }
    FA_BAR();
    issue_first(nx, pc, lds, wid, lane);
    scale_rows(o, 1.f / l, wsf, r32, hi);
    stage_o(o, stg, r32, hi);
    emit_y(stg, zz, Y, (size_t)b * SEQ + tw0, 256, h, lane);
}
__device__ __forceinline__ void stick_unit(const bf16* P, bf16* Y, int unit, LAS unsigned char* lds, int tid, bool pre, const NextUnit& nx, const PreCtx& pc) {
    asm volatile("" : "+v"(tid));
    const int lane = tid & 63, wid = __builtin_amdgcn_readfirstlane(tid >> 6), r32 = lane & 31, hi = lane >> 5;
    const int b = unit >> 7, hs = wid >> 2, h = 2 * ((unit >> 6) & 1) + hs, pos0 = (unit & 63) * 128, tw0 = pos0 + 32 * (wid & 3), t = tw0 + r32;
    const bf16* Pb = P + (size_t)b * SEQ * PW;
    bf16x8 qr[4];
#pragma unroll
    for (int d0 = 0; d0 < 4; ++d0) qr[d0] = *(const bf16x8*)(Pb + (size_t)t * PW + C_Q + h * 64 + d0 * 16 + hi * 8);
    u32x4 zz[4]; load_z(zz, P, (size_t)b * SEQ + tw0, C_Z, h, lane);
    float carry = 1.f; f32x16 o[2];
#pragma unroll
    for (int r = 0; r < 16; ++r) { o[0][r] = 0.f; o[1][r] = 0.f; }
    LAS float* stg = (LAS float*)(lds + L_STG) + wid * 2048; volatile LAS unsigned* flags = (volatile LAS unsigned*)(lds + L_FLG);
    const int jtop = (pos0 + 126) >> 6, h0 = 2 * ((unit >> 6) & 1);
    if (lane == 0) { flags[wid] = 0u; flags[8 + wid] = 0u; }
    const bf16* kb = Pb + C_K + h0 * 64; const bf16* vb = Pb + C_V + h0 * 64;
#define STK_ISSUE(j, pr) do { dma_tile(kb + (size_t)(64 * (j)) * PW, vb + (size_t)(64 * (j)) * PW, PW, lds + (2 * (pr)) * SLOT, wid, lane); \
                              dma_tile(kb + 64 + (size_t)(64 * (j)) * PW, vb + 64 + (size_t)(64 * (j)) * PW, PW, lds + (2 * (pr) + 1) * SLOT, wid, lane); } while (0)
    int t0 = jtop, it = 0; bool done = false;
    if (!pre) STK_ISSUE(jtop, 0);
    while (t0 >= 0) {
        FA_WAIT(0);
        FA_BAR();
        { unsigned nd = 0; const volatile LAS unsigned* fl = flags + (it & 1) * 8;
#pragma unroll
          for (int w = 0; w < 8; ++w) nd += fl[w];
          if (__builtin_amdgcn_readfirstlane(nd) == 8u) break; }
        if (t0 >= 1) STK_ISSUE(t0 - 1, (it + 1) & 1);
        const int j = t0; const LAS unsigned char* kt = lds + (2 * (it & 1) + hs) * SLOT;
        if (!done && 64 * j <= tw0 + 30) {
            f32x16 p0, p1, s0, s1; qkt(p0, p1, kt, qr, r32, hi);
            const int d0 = t - (64 * j + 4 * hi);
            constexpr float NC = -0.125f * LOG2E;
            if (64 * j + 63 < tw0) {
#pragma unroll
                for (int r = 0; r < 16; ++r) { const float e0 = __builtin_amdgcn_exp2f(fminf(p0[r] * NC, 115.f)), e1 = __builtin_amdgcn_exp2f(fminf(p1[r] * NC, 115.f));
                    const float b0 = __builtin_amdgcn_rcpf(1.f + e0), b1 = __builtin_amdgcn_rcpf(1.f + e1);
                    p0[r] = b0; p1[r] = b1; s0[r] = e0 * b0; s1[r] = e1 * b1; }
            } else {
#pragma unroll
            for (int r = 0; r < 16; ++r) { const int d = d0 - ((r & 3) + 8 * (r >> 2)), e = d - 32;
                const float e0 = __builtin_amdgcn_exp2f(fminf(p0[r] * NC, 115.f)), e1 = __builtin_amdgcn_exp2f(fminf(p1[r] * NC, 115.f));
                const float b0 = __builtin_amdgcn_rcpf(1.f + e0), b1 = __builtin_amdgcn_rcpf(1.f + e1);
                p0[r] = (d >= 1) ? b0 : 0.f; p1[r] = (e >= 1) ? b1 : 0.f; s0[r] = (d >= 1) ? e0 * b0 : 1.f; s1[r] = (e >= 1) ? e1 * b1 : 1.f; }
            }
            float T[8], PT[8], after[8];
#pragma unroll
            for (int k = 0; k < 4; ++k) { T[k] = (s0[4 * k] * s0[4 * k + 1]) * (s0[4 * k + 2] * s0[4 * k + 3]); T[4 + k] = (s1[4 * k] * s1[4 * k + 1]) * (s1[4 * k + 2] * s1[4 * k + 3]); }
#pragma unroll
            for (int k = 0; k < 8; ++k) { auto rr = __builtin_amdgcn_permlane32_swap(__float_as_uint(T[k]), __float_as_uint(T[k]), false, false); PT[k] = __uint_as_float(hi ? rr[0] : rr[1]); }
            float aT = 1.f, aP = 1.f;
#pragma unroll
            for (int k = 7; k >= 0; --k) { after[k] = aT * (hi ? aP : aP * PT[k]); aT *= T[k]; aP *= PT[k]; }
#pragma unroll
            for (int k = 0; k < 4; ++k) { float run0 = after[k] * carry, run1 = after[4 + k] * carry;
#pragma unroll
                for (int e = 3; e >= 0; --e) { const int r = 4 * k + e;
                    const float w0 = p0[r] * run0, w1 = p1[r] * run1;
                    run0 *= s0[r]; run1 *= s1[r]; p0[r] = w0; p1[r] = w1; } }
            carry *= aT * aP;
            u32x4 pw[4]; pack_p(pw, p0, p1); pv(o, kt + 8192, pw, lane);
            done = __all(carry == 0.f);
        }
        if (lane == 0) flags[((it + 1) & 1) * 8 + wid] = (done || j == 0) ? 1u : 0u;
        --t0; ++it;
    }
#undef STK_ISSUE
    FA_WAIT(0); FA_BAR();
    issue_first(nx, pc, lds, wid, lane);
    stage_o(o, stg, r32, hi);
    emit_y(stg, zz, Y, (size_t)b * SEQ + tw0, 512, h, lane);
}
__device__ __forceinline__ void ret_unit(const bf16* P, const float* R, bf16* Y, int unit, LAS unsigned char* lds, int tid, bool pre, const NextUnit& nx, const PreCtx& pc) {
    asm volatile("" : "+v"(tid));
    const int lane = tid & 63, wid = __builtin_amdgcn_readfirstlane(tid >> 6), r32 = lane & 31, hi = lane >> 5;
    const int b = unit >> 7, h = (unit >> 5) & 3, pos0 = (unit & 31) * 256, ch = wid >> 2, n = (pos0 >> 7) + ch, i0 = 32 * (wid & 3), i = i0 + r32, tw0 = pos0 + 128 * ch + i0;
    const bf16* Pb = P + (size_t)b * SEQ * PW;
    bf16x8 qr[4];
#pragma unroll
    for (int d0 = 0; d0 < 4; ++d0) qr[d0] = *(const bf16x8*)(Pb + (size_t)(tw0 + r32) * PW + D_Q + h * 64 + d0 * 16 + hi * 8);
    const float lg2 = __builtin_amdgcn_logf(1.f - exp2f(-5.f - (float)h));
    u32x4 zz[4]; load_z(zz, P, (size_t)b * SEQ + tw0, D_Z, h, lane);
    float cG[16]; const float g32 = __builtin_amdgcn_exp2f(lg2 * -32.f);
#pragma unroll
    for (int r = 0; r < 16; ++r) cG[r] = __builtin_amdgcn_exp2f(-lg2 * (float)((r & 3) + 8 * (r >> 2)));
    f32x16 o[2], o2[2];
#pragma unroll
    for (int r = 0; r < 16; ++r) { o[0][r] = 0.f; o[1][r] = 0.f; o2[0][r] = 0.f; o2[1][r] = 0.f; }
    LAS float* wsf = (LAS float*)(lds + L_WSF) + wid * 64; LAS float* stg = (LAS float*)(lds + L_STG) + wid * 2048;
    const int j0 = pos0 >> 6;
    const bf16* kb = Pb + D_K + h * 64; const bf16* vb = Pb + D_V + h * 64;
    if (!pre) {
#pragma unroll
    for (int tt = 0; tt < 4; ++tt) dma_tile(kb + (size_t)(64 * (j0 + tt)) * PW, vb + (size_t)(64 * (j0 + tt)) * PW, PW, lds + (2 * (tt & 1) + (tt >> 1)) * SLOT, wid, lane);
    }
    { const float* Rn = R + ((((size_t)b * 64 + n) * 4 + h) * 64) * 64;
#pragma unroll
      for (int d0 = 0; d0 < 4; ++d0)
#pragma unroll
          for (int eh = 0; eh < 2; ++eh) { const float* rp = Rn + (size_t)(16 * d0 + 8 * hi) * 64 + 32 * eh + r32;
              u32x4 w; w.x = cvt_pk_bf16(rp[0], rp[64]); w.y = cvt_pk_bf16(rp[128], rp[192]); w.z = cvt_pk_bf16(rp[256], rp[320]); w.w = cvt_pk_bf16(rp[384], rp[448]);
              o2[eh] = __builtin_amdgcn_mfma_f32_32x32x16_bf16(qr[d0], __builtin_bit_cast(bf16x8, w), o2[eh], 0, 0, 0); } }
    FA_WAIT(0); FA_BAR();
#pragma unroll
    for (int tl = 0; tl < 2; ++tl) {
        if (64 * tl <= i0 + 31) {
            const LAS unsigned char* kt = lds + (2 * tl + ch) * SLOT;
            f32x16 p0, p1; qkt(p0, p1, kt, qr, r32, hi);
            const int d0 = i - (64 * tl + 4 * hi);
            const float rf0 = 0.125f * __builtin_amdgcn_exp2f(lg2 * (float)d0), rf1 = rf0 * g32;
            if (64 * tl + 63 <= i0) {
#pragma unroll
                for (int r = 0; r < 16; ++r) { p0[r] = p0[r] * rf0 * cG[r]; p1[r] = p1[r] * rf1 * cG[r]; }
            } else {
#pragma unroll
                for (int r = 0; r < 16; ++r) { const int d = d0 - ((r & 3) + 8 * (r >> 2)), e = d - 32;
                    p0[r] = (d >= 0) ? p0[r] * rf0 * cG[r] : 0.f; p1[r] = (e >= 0) ? p1[r] * rf1 * cG[r] : 0.f; }
            }
            u32x4 pw[4]; pack_p(pw, p0, p1); pv(o, kt + 8192, pw, lane);
        }
    }
    FA_BAR();
    issue_first(nx, pc, lds, wid, lane);
    scale_rows(o2, 0.125f * __builtin_amdgcn_exp2f(lg2 * (float)(i + 1)), wsf, r32, hi);
#pragma unroll
    for (int r = 0; r < 16; ++r) { o[0][r] += o2[0][r]; o[1][r] += o2[1][r]; }
    stage_o(o, stg, r32, hi);
    { const size_t m0 = (size_t)b * SEQ + tw0;
#pragma unroll
      for (int it = 0; it < 4; ++it) { const int row = it * 8 + (lane >> 3), c8 = lane & 7;
          const f32x4 a = *(const LAS f32x4*)(stg + row * 64 + c8 * 8), c = *(const LAS f32x4*)(stg + row * 64 + c8 * 8 + 4);
          float sm = (a.x + a.y) + (a.z + a.w) + (c.x + c.y) + (c.z + c.w);
          sm += xshfl<1>(sm); sm += xshfl<2>(sm); sm += xshfl<4>(sm);
          const float mu = sm * (1.f / 64.f); const f32x4 da = a - mu, dc = c - mu;
          float vs = (da.x * da.x + da.y * da.y) + (da.z * da.z + da.w * da.w) + (dc.x * dc.x + dc.y * dc.y) + (dc.z * dc.z + dc.w * dc.w);
          vs += xshfl<1>(vs); vs += xshfl<2>(vs); vs += xshfl<4>(vs);
          const float rs = rsqrtf(vs * (1.f / 64.f) + 1e-5f);
          const u32x4 z = zz[it];
          u32x4 w; w.x = cvt_pk_bf16(da.x * rs * siluf_(bflo(z.x)), da.y * rs * siluf_(bfhi(z.x))); w.y = cvt_pk_bf16(da.z * rs * siluf_(bflo(z.y)), da.w * rs * siluf_(bfhi(z.y)));
          w.z = cvt_pk_bf16(dc.x * rs * siluf_(bflo(z.z)), dc.y * rs * siluf_(bfhi(z.z))); w.w = cvt_pk_bf16(dc.z * rs * siluf_(bflo(z.w)), dc.w * rs * siluf_(bfhi(z.w)));
          *(u32x4*)(Y + (m0 + row) * DM + 768 + h * 64 + c8 * 8) = w; } }
}
__device__ __forceinline__ void nsa_unit(const bf16* P, const bf16* KCB, const bf16* VCB, bf16* Y, int unit, LAS unsigned char* lds, int tid, bool pre, const NextUnit& nx, const PreCtx& pc) {
    asm volatile("" : "+v"(tid));
    const int lane = tid & 63, wid = __builtin_amdgcn_readfirstlane(tid >> 6), r32 = lane & 31, hi = lane >> 5;
    const int b = unit >> 7, pos0 = ((b & 2) ? 127 - (unit & 127) : (unit & 127)) * 64, cur = pos0 >> 6;
    const bf16* Pb = P + (size_t)b * SEQ * PW;
    LAS float* OA = (LAS float*)(lds + L_STG); LAS unsigned* selm = (LAS unsigned*)(lds + L_SEL); LAS unsigned* uni = (LAS unsigned*)(lds + L_UNI); LAS float* wsf = (LAS float*)(lds + L_WSF) + wid * 64;
    LAS float* stg = OA + wid * 2048;
    const float scale2 = 0.125f * LOG2E;
    const int pl = r32 >> 2, h = r32 & 3, t = pos0 + 8 * wid + pl;
    const float slope2 = exp2f(-2.f * (float)(h + 1)) * LOG2E;
    bf16x8 qr[4];
#pragma unroll
    for (int d0 = 0; d0 < 4; ++d0) qr[d0] = *(const bf16x8*)(Pb + (size_t)t * PW + A_Q + h * 64 + d0 * 16 + hi * 8);
    const bf16 gl0 = Pb[(size_t)t * PW + A_G + 3 * h], gl1 = Pb[(size_t)t * PW + A_G + 3 * h + 1], gl2 = Pb[(size_t)t * PW + A_G + 3 * h + 2];
    u32x4 zz[4];
#pragma unroll
    for (int it = 0; it < 4; ++it) { const int row = 32 * wid + it * 8 + (lane >> 3); zz[it] = *(const u32x4*)(Pb + (size_t)(pos0 + (row >> 2)) * PW + A_Z + (row & 3) * 64 + (lane & 7) * 8); }
    for (int rep1_ = 0; rep1_ < NREP(10); ++rep1_) {
        const int ncvmax = (pos0 >> 5) + 2, ntile = (ncvmax + 63) >> 6;
        if (tid < 4) uni[tid] = 0u;
        if (!(pre && rep1_ == 0))
        for (int tl = 0; tl < ntile; ++tl) {
            __builtin_amdgcn_global_load_lds((const unsigned*)(KCB + ((size_t)b * 256 + 64 * tl + lane) * 64 + wid * 8), (LAS unsigned*)(lds + tl * 8192 + wid * 1024), 16, 0, 0);
            __builtin_amdgcn_global_load_lds((const unsigned*)(VCB + ((size_t)b * 256 + 64 * tl + 16 * (wid & 3) + (lane >> 2)) * 64 + (wid >> 2) * 32 + (lane & 3) * 8), (LAS unsigned*)(lds + 32768 + tl * 8192 + wid * 1024), 16, 0, 0); }
        FA_WAIT(0); FA_BAR();
        const int ncv = (t >= 31) ? (((t - 31) >> 5) + 1) : 0;
        float m = -1e30f, l = 0.f;
        for (int tl = 0; tl < ntile; ++tl) {
            f32x16 p0, p1; qkt(p0, p1, lds + tl * 8192, qr, r32, hi);
            const int c0 = 64 * tl + 4 * hi; float rm = -1e30f;
#pragma unroll
            for (int r = 0; r < 16; ++r) { const int c = c0 + (r & 3) + 8 * (r >> 2);
                p0[r] = (c < ncv) ? p0[r] * scale2 - slope2 * (float)(t - 32 * c - 31) : -1e30f; p1[r] = (c + 32 < ncv) ? p1[r] * scale2 - slope2 * (float)(t - 32 * (c + 32) - 31) : -1e30f;
                rm = fmaxf(rm, fmaxf(p0[r], p1[r])); }
            rm = xmax32(rm); const float mn = fmaxf(m, rm); float rs = 0.f;
#pragma unroll
            for (int r = 0; r < 16; ++r) { rs += (p0[r] > -1e29f ? __builtin_amdgcn_exp2f(p0[r] - mn) : 0.f) + (p1[r] > -1e29f ? __builtin_amdgcn_exp2f(p1[r] - mn) : 0.f); }
            l = l * __builtin_amdgcn_exp2f(m - mn) + xsum32(rs); m = mn;
        }
        const float inv = l > 0.f ? 1.f / l : 0.f;
        f32x16 o[2];
#pragma unroll
        for (int r = 0; r < 16; ++r) { o[0][r] = 0.f; o[1][r] = 0.f; }
        LAS float* impw = stg;
        for (int tl = 0; tl < ntile; ++tl) {
            f32x16 p0, p1; qkt(p0, p1, lds + tl * 8192, qr, r32, hi);
            const int c0 = 64 * tl + 4 * hi;
#pragma unroll
            for (int r = 0; r < 16; ++r) { const int c = c0 + (r & 3) + 8 * (r >> 2);
                p0[r] = (c < ncv) ? __builtin_amdgcn_exp2f(p0[r] * scale2 - slope2 * (float)(t - 32 * c - 31) - m) * inv : 0.f;
                p1[r] = (c + 32 < ncv) ? __builtin_amdgcn_exp2f(p1[r] * scale2 - slope2 * (float)(t - 32 * (c + 32) - 31) - m) * inv : 0.f; }
#pragma unroll
            for (int r = 0; r < 16; r += 2) { float a0 = p0[r] + p0[r + 1], a1 = p1[r] + p1[r + 1];
                a0 += xshfl<1>(a0); a0 += xshfl<2>(a0); a1 += xshfl<1>(a1); a1 += xshfl<2>(a1);
                const int jl = ((r & 3) >> 1) + 4 * (r >> 2) + 2 * hi;
                if (h == 0) { impw[pl * 128 + 32 * tl + jl] = a0; impw[pl * 128 + 32 * tl + 16 + jl] = a1; } }
            u32x4 pw[4]; pack_p(pw, p0, p1); pv(o, lds + 32768 + tl * 8192, pw, lane);
        }
        { const int pq = lane >> 3, sub = lane & 7; unsigned bits = 0u;
          if (cur <= 15) {
#pragma unroll
              for (int c = 0; c < 16; ++c) bits |= (sub * 16 + c <= cur) ? (1u << c) : 0u;
          } else {
              float cand[16]; const int kend = cur - 2;
#pragma unroll
              for (int c = 0; c < 16; ++c) { const int jc = sub * 16 + c; cand[c] = (jc >= 1 && jc <= kend) ? impw[pq * 128 + jc] : -1.f;
                  bits |= ((jc == 0) || (jc == cur) || (jc == cur - 1)) ? (1u << c) : 0u; }
              for (int round = 0; round < 13; ++round) {
                  float vm = cand[0];
#pragma unroll
                  for (int c = 1; c < 16; ++c) vm = fmaxf(vm, cand[c]);
                  vm = fmaxf(vm, __uint_as_float(__builtin_amdgcn_update_dpp(0, __float_as_uint(vm), 0xB1, 0xF, 0xF, true)));
                  vm = fmaxf(vm, __uint_as_float(__builtin_amdgcn_update_dpp(0, __float_as_uint(vm), 0x4E, 0xF, 0xF, true)));
                  vm = fmaxf(vm, __uint_as_float(__builtin_amdgcn_update_dpp(0, __float_as_uint(vm), 0x141, 0xF, 0xF, true)));
                  int idx = 255;
#pragma unroll
                  for (int c = 15; c >= 0; --c) idx = (cand[c] == vm) ? sub * 16 + c : idx;
                  idx = min(idx, (int)__builtin_amdgcn_update_dpp(0, (unsigned)idx, 0xB1, 0xF, 0xF, true));
                  idx = min(idx, (int)__builtin_amdgcn_update_dpp(0, (unsigned)idx, 0x4E, 0xF, 0xF, true));
                  idx = min(idx, (int)__builtin_amdgcn_update_dpp(0, (unsigned)idx, 0x141, 0xF, 0xF, true));
#pragma unroll
                  for (int c = 0; c < 16; ++c) { const bool hit = (sub * 16 + c == idx) && (vm >= 0.f); bits |= hit ? (1u << c) : 0u; cand[c] = hit ? -1.f : cand[c]; }
              }
          }
          ((LAS unsigned short*)selm)[(8 * wid + pq) * 8 + sub] = (unsigned short)bits;
          (void)__hip_atomic_fetch_or(uni + (sub >> 1), bits << (16 * (sub & 1)), __ATOMIC_RELAXED, __HIP_MEMORY_SCOPE_WORKGROUP); }
        const float g0 = sigmoidf_(bf2f(gl0));
        scale_rows(o, g0, wsf, r32, hi);
        stage_o(o, stg, r32, hi);
    }
    FA_WAIT(0); FA_BAR();
    {
        unsigned selw[4], un[4];
#pragma unroll
        for (int i = 0; i < 4; ++i) { selw[i] = selm[(8 * wid + pl) * 4 + i]; un[i] = __builtin_amdgcn_readfirstlane(uni[i]); }
        const float g1 = sigmoidf_(bf2f(gl1)), g2 = sigmoidf_(bf2f(gl2));
        float cK[16];
#pragma unroll
        for (int r = 0; r < 16; ++r) cK[r] = slope2 * (float)((r & 3) + 8 * (r >> 2));
        for (int rep2_ = 0; rep2_ < NREP(11); ++rep2_)
        for (int br = 0; br < 2; ++br) {
            const bf16* kb = Pb + A_KV + (br ? 256 : 128); const bf16* vb = kb + 64;
            float m = -1e30f, l = 0.f; f32x16 o[2];
#pragma unroll
            for (int r = 0; r < 16; ++r) { o[0][r] = 0.f; o[1][r] = 0.f; }
            const int jlow = br ? (cur >= 8 ? cur - 8 : 0) : 0;
            tile_stream(cur,
                [&](int j) { if (br) return j > jlow ? j - 1 : -1;
                             if (j <= 0) return -1;
                             const int q = j - 1; int w = q >> 5; unsigned mk = (w == 0 ? un[0] : w == 1 ? un[1] : w == 2 ? un[2] : un[3]) & (0xffffffffu >> (31 - (q & 31)));
                             for (;;) { if (mk) return w * 32 + 31 - __builtin_clz(mk); if (--w < 0) return -1; mk = (w == 0 ? un[0] : w == 1 ? un[1] : un[2]); } },
                [&](int j, int sl) { dma_tile(kb + (size_t)(64 * j) * PW, vb + (size_t)(64 * j) * PW, PW, lds + sl * SLOT, wid, lane); },
                [&](int j, int sl) {
                    const bool mine = br ? true : (((selw[j >> 5] >> (j & 31)) & 1u) != 0u);
                    if (__any(mine)) {
                        const LAS unsigned char* kt = lds + sl * SLOT;
                        f32x16 p0, p1; qkt(p0, p1, kt, qr, r32, hi);
                        const int d0 = t - (64 * j + 4 * hi);
                        if (br ? (j < cur && j > cur - 8) : (j < cur)) {
                            const float b0 = -slope2 * (float)d0, b1 = b0 + 32.f * slope2;
                            float rm0 = -1e30f, rm1 = -1e30f;
#pragma unroll
                            for (int r = 0; r < 16; ++r) { p0[r] = p0[r] * scale2 + cK[r]; p1[r] = p1[r] * scale2 + cK[r]; rm0 = fmaxf(rm0, p0[r]); rm1 = fmaxf(rm1, p1[r]); }
                            float rm = fmaxf(rm0 + b0, rm1 + b1); rm = mine ? rm : -1e30f; rm = xmax32(rm);
                            const float mn = (rm > m + 8.f) ? rm : m, f = __builtin_amdgcn_exp2f(m - mn); m = mn;
                            const float off0 = mine ? mn - b0 : 1e30f, off1 = mine ? mn - b1 : 1e30f; float rs = 0.f;
#pragma unroll
                            for (int r = 0; r < 16; ++r) { p0[r] = __builtin_amdgcn_exp2f(p0[r] - off0); p1[r] = __builtin_amdgcn_exp2f(p1[r] - off1); rs += p0[r] + p1[r]; }
                            l = l * f + xsum32(rs);
                            if (__any(f != 1.f)) scale_rows(o, f, wsf, r32, hi);
                        } else {
#pragma unroll
                            for (int r = 0; r < 16; ++r) { const int d = d0 - ((r & 3) + 8 * (r >> 2)), e = d - 32;
                                const bool v0 = br ? (d >= 0 && d < 512) : (mine && d >= 0), v1 = br ? (e >= 0 && e < 512) : (mine && e >= 0);
                                p0[r] = v0 ? p0[r] * scale2 - slope2 * (float)d : -1e30f; p1[r] = v1 ? p1[r] * scale2 - slope2 * (float)e : -1e30f; }
                            softmax_step(p0, p1, m, l, o, wsf, r32, hi);
                        }
                        u32x4 pw[4]; pack_p(pw, p0, p1); pv(o, kt + 8192, pw, lane);
                    } });
            scale_rows(o, rep2_ ? 0.f : (l > 0.f ? 1.f / l : 0.f) * (br ? g2 : g1), wsf, r32, hi);
#pragma unroll
            for (int r = 0; r < 16; ++r) { LAS float* orow = stg + crow(r, hi) * 64 + r32; orow[0] += o[0][r]; orow[32] += o[1][r]; }
        }
    }
    issue_first(nx, pc, lds, wid, lane);
    { const size_t mb = (size_t)b * SEQ + pos0;
#pragma unroll
      for (int it = 0; it < 4; ++it) { const int row = 32 * wid + it * 8 + (lane >> 3), c8 = lane & 7, pq = row >> 2, hh = row & 3;
          const f32x4 a = *(const LAS f32x4*)(OA + row * 64 + c8 * 8), c = *(const LAS f32x4*)(OA + row * 64 + c8 * 8 + 4);
          const u32x4 z = zz[it];
          u32x4 w; w.x = cvt_pk_bf16(a.x * siluf_(bflo(z.x)), a.y * siluf_(bfhi(z.x))); w.y = cvt_pk_bf16(a.z * siluf_(bflo(z.y)), a.w * siluf_(bfhi(z.y)));
          w.z = cvt_pk_bf16(c.x * siluf_(bflo(z.z)), c.y * siluf_(bfhi(z.z))); w.w = cvt_pk_bf16(c.z * siluf_(bflo(z.w)), c.w * siluf_(bfhi(z.w)));
          *(u32x4*)(Y + (mb + pq) * DM + hh * 64 + c8 * 8) = w; } }
}
__device__ __forceinline__ void ustate_unit(const bf16* P, float* U, int unit, LAS unsigned char* lds, int tid) {
    asm volatile("" : "+v"(tid));
    const int lane = tid & 63, wid = __builtin_amdgcn_readfirstlane(tid >> 6), r32 = lane & 31, hi = lane >> 5;
    const int b = unit >> 7, h = (unit >> 5) & 3, pos0 = (unit & 31) * 256, ch = wid >> 2, dh = (wid >> 1) & 1, eh = wid & 1;
    const bf16* kb = P + ((size_t)b * SEQ + pos0) * PW + D_K + h * 64; const bf16* vb = P + ((size_t)b * SEQ + pos0) * PW + D_V + h * 64;
    const size_t roff = (size_t)(16 * (wid & 3) + (lane >> 2)) * PW + (wid >> 2) * 32 + (lane & 3) * 8;
#pragma unroll
    for (int tt = 0; tt < 4; ++tt) {
        __builtin_amdgcn_global_load_lds((const unsigned*)(kb + (size_t)(64 * tt) * PW + roff), (LAS unsigned*)(lds + tt * SLOT + wid * 1024), 16, 0, 0);
        __builtin_amdgcn_global_load_lds((const unsigned*)(vb + (size_t)(64 * tt) * PW + roff), (LAS unsigned*)(lds + tt * SLOT + 8192 + wid * 1024), 16, 0, 0); }
    FA_WAIT(0); FA_BAR();
    const float lg2 = __builtin_amdgcn_logf(1.f - exp2f(-5.f - (float)h));
    f32x16 acc;
#pragma unroll
    for (int r = 0; r < 16; ++r) acc[r] = 0.f;
    const int voff = ((lane >> 4) & 1) * 32 + (lane & 3) * 8 + (4 * hi + ((lane & 15) >> 2)) * 64;
#pragma unroll
    for (int t2 = 0; t2 < 2; ++t2) { const LAS unsigned char* kt = lds + (2 * ch + t2) * SLOT + voff;
#pragma unroll
        for (int ks = 0; ks < 4; ++ks) {
            const s16x4 klo = vtr(kt + dh * 4096 + ks * 1024), khi = vtr(kt + dh * 4096 + ks * 1024 + 512), vlo = vtr(kt + 8192 + eh * 4096 + ks * 1024), vhi = vtr(kt + 8192 + eh * 4096 + ks * 1024 + 512);
            const int jb = 64 * t2 + 16 * ks + 4 * hi; float kz[8];
#pragma unroll
            for (int e = 0; e < 4; ++e) { kz[e] = bf2f((bf16)klo[e]) * __builtin_amdgcn_exp2f(lg2 * (float)(127 - (jb + e))); kz[4 + e] = bf2f((bf16)khi[e]) * __builtin_amdgcn_exp2f(lg2 * (float)(127 - (jb + 8 + e))); }
            const u32x4 kw = (u32x4){cvt_pk_bf16(kz[0], kz[1]), cvt_pk_bf16(kz[2], kz[3]), cvt_pk_bf16(kz[4], kz[5]), cvt_pk_bf16(kz[6], kz[7])};
            const bf16x8 vf = (bf16x8){vlo[0], vlo[1], vlo[2], vlo[3], vhi[0], vhi[1], vhi[2], vhi[3]};
            acc = __builtin_amdgcn_mfma_f32_32x32x16_bf16(__builtin_bit_cast(bf16x8, kw), vf, acc, 0, 0, 0); } }
    float* ud = U + ((((size_t)b * 64 + (pos0 >> 7) + ch) * 4 + h) * 64 + 32 * dh) * 64 + 32 * eh + r32;
#pragma unroll
    for (int r = 0; r < 16; ++r) st_wt(ud + (size_t)crow(r, hi) * 64, acc[r]);
    FA_BAR();
}
}

typedef const __attribute__((address_space(4))) Args* KArgs;
#define PH_PTRS() KArgs kp = ka; asm volatile("" : "+s"(kp)); unsigned char* const ws = kp->ws; (void)ws; int tid = (wave << 6) | lane_id_now(); const int lane = tid & 63; (void)lane; int gwl = gw; asm volatile("" : "+s"(gwl)); (void)gwl
__global__ void __launch_bounds__(NTHREADS, 2) hybrid_fwd(Args args_byval) {
    extern __shared__ __attribute__((aligned(16))) unsigned char lds_raw[];
    LAS unsigned char* lds = (LAS unsigned char*)lds_raw;
    volatile LAS unsigned* MISC = (volatile LAS unsigned*)(lds + MISC_OFF);
    const KArgs ka = (KArgs)__builtin_amdgcn_kernarg_segment_ptr();
    const int tid0 = threadIdx.x, wave = __builtin_amdgcn_readfirstlane(tid0 >> 6);
    const int G = gridDim.x, gw = blockIdx.x * NWAVES + wave, NGW = G * NWAVES;
    const int vcu = (G % 8 == 0) ? ((int)blockIdx.x % 8) * (G / 8) + (int)blockIdx.x / 8 : (int)blockIdx.x;
    for (int u = tid0; u < (LDS_BYTES - LDSCTL_OFF) / 4; u += NTHREADS) ((LAS unsigned*)(lds + LDSCTL_OFF))[u] = 0u;
    __syncthreads();
    XcdBarrier bar; bar.bar = (unsigned*)(args_byval.ws + WS_CTL) + CW_BAR; bar.x = 0; bar.st = nullptr;
    if (MK_N_LAUNCHES == 1) bar = xcd_barrier_post(bar.bar, MISC + 8);
    bar.wave = wave;
#if MK_N_LAUNCHES == 1
#define IN(k) true
#else
    const int lo = args_byval.ph_lo, hi = args_byval.ph_hi;
#define IN(k) (lo <= (k) && (k) < hi)
#endif
#define SEAM(k) do { if (IN(k) && IN((k) + 1)) { if (MK_N_LAUNCHES == 1) { for (int rb_ = 0; rb_ < NREP(12); ++rb_) xcd_barrier(bar); } } } while (0)
    LAS float* wl = (LAS float*)(lds + wave * 8192);

    if (IN(0)) {
        PH_PTRS();
        bf16* WIN_T = (bf16*)(ws + WS_WIN); bf16* WCAT_T = (bf16*)(ws + WS_WCAT); bf16* WO_T = (bf16*)(ws + WS_WO); float* MOD = (float*)(ws + WS_MOD);
        LAS float* scr = (LAS float*)(lds + wave * 16384);
        constexpr int I_WIN = DEPTH * 16 * 120, I_G = 16 * 16 * 32, I_B = 16 * 4 * 32, I_O = DEPTH * 16 * 32, I_W1 = DEPTH * 2 * 32 * 2, I_P1 = DEPTH * 2 * 8;
        for (int rep_ = 0; rep_ < NREP(0); ++rep_)
        for (int it = gwl; it < I_WIN + I_G + I_B + I_O + I_W1 + I_P1; it += NGW) {
            int r = it;
            if (r >= I_WIN + I_G + I_B + I_O) { r -= I_WIN + I_G + I_B + I_O;
                if (r < I_W1) { const int mat = r >> 6, q = r & 63; transpose_item<false>(kp->cmp_w1 + (size_t)mat * 2048 * 64, 64, (bf16*)(ws + WS_W1T) + (size_t)mat * 64 * 2048, 2048, 0, scr, q >> 1, q & 1, lane); continue; }
                r -= I_W1; { const int mat = r >> 3, sl = r & 7; const float* w1 = kp->cmp_w1 + ((size_t)mat * 2048 + 256 * sl) * 64 + lane; const float* pos = kp->cmp_pos + (size_t)mat * 2048 + 256 * sl; float a = 0.f;
#pragma unroll 8
                    for (int i = 0; i < 256; ++i) a += pos[i] * w1[(size_t)i * 64];
                    ((float*)(ws + WS_B1P))[(mat * 8 + sl) * 64 + lane] = a; }
                continue; }
            if (r < I_WIN) { const int l = r / (16 * 120), q = r % (16 * 120); transpose_item<true>(kp->w_in + (size_t)l * DM * INW, INW, WIN_T + (size_t)l * PW * DM, DM, 0, scr, q / 120, q % 120, lane); continue; } r -= I_WIN;
            if (r < I_G) { const int li = r / 512, q = r % 512; transpose_item<false>(kp->w_merge + (size_t)li * DM * DM, DM, WCAT_T + (size_t)li * DM * KCAT, KCAT, 0, scr, q / 32, q % 32, lane); continue; } r -= I_G;
            if (r < I_B) { const int li = r / 128, q = r % 128; transpose_item<false>(kp->w_br + (size_t)li * 256 * DM, DM, WCAT_T + (size_t)li * DM * KCAT, KCAT, 1024, scr, q / 32, q % 32, lane); continue; } r -= I_B;
            { const int l = r / 512, q = r % 512; transpose_item<false>(kp->w_out + (size_t)l * DM * DM, DM, WO_T + (size_t)l * DM * DM, DM, 0, scr, q / 32, q % 32, lane); }
        }
        __syncthreads();
        LAS float* red = (LAS float*)lds;
        const float* cvec = kp->c;
        for (int rep_ = 0; rep_ < NREP(13); ++rep_)
        for (int u = blockIdx.x; u < DEPTH * 48; u += G) {
            const int l = u / 48, col = (u % 48) * 64 + lane; float a[4] = {0.f, 0.f, 0.f, 0.f};
            const float* wa = kp->w_ada + (size_t)l * DM * 3072 + col;
            for (int k0 = wave * 128; k0 < wave * 128 + 128; k0 += 16) { float wv[16];
#pragma unroll
                for (int i = 0; i < 16; ++i) wv[i] = wa[(size_t)(k0 + i) * 3072];
#pragma unroll
                for (int i = 0; i < 16; ++i)
#pragma unroll
                    for (int b = 0; b < 4; ++b) a[b] += siluf_(cvec[b * DM + k0 + i]) * wv[i]; }
#pragma unroll
            for (int b = 0; b < 4; ++b) red[(wave * 4 + b) * 64 + lane] = a[b];
            __syncthreads();
            if (wave < 4) { float s = kp->b_ada[(size_t)l * 3072 + col];
#pragma unroll
                for (int w = 0; w < 8; ++w) s += red[(w * 4 + wave) * 64 + lane];
                MOD[((size_t)l * 4 + wave) * 3072 + col] = s; }
            __syncthreads();
        }
    }
    SEAM(0);
    if (IN(1)) {
        PH_PTRS();
        const float* MOD = (const float*)(ws + WS_MOD);
        float* GS = (float*)(ws + WS_GS);
        for (int idx = blockIdx.x * NTHREADS + tid; idx < DEPTH * NBATCH * DM; idx += G * NTHREADS) { const int lb = idx >> 10, c = idx & 1023; GS[idx] = kp->norm_g[(lb >> 2) * DM + c] * (1.f + MOD[(size_t)lb * 3072 + 1024 + c]); }
        constexpr int T_IN = DEPTH * PW, T_MG = DEPTH * 4096;
        for (int tb = 4 * gwl; tb < T_IN + T_MG; tb += 4 * NGW) {
            u32x4 w0[4], w1[4];
#pragma unroll
            for (int q = 0; q < 4; ++q) { const int task = tb + q; const bf16* wrow;
                if (task < T_IN) wrow = (const bf16*)(ws + WS_WIN) + (size_t)task * DM; else wrow = (const bf16*)(ws + WS_WCAT) + (size_t)(task - T_IN) * KCAT;
                w0[q] = *(const u32x4*)(wrow + 8 * lane); w1[q] = *(const u32x4*)(wrow + 512 + 8 * lane); }
#pragma unroll
            for (int q = 0; q < 4; ++q) { const int task = tb + q; int l, n; float* dst; int dpitch;
                if (task < T_IN) { l = task / PW; n = task % PW; dst = (float*)(ws + WS_SW) + (size_t)l * NBATCH * PW + n; dpitch = PW; }
                else { const int qq = task - T_IN; l = qq >> 12; n = qq & 4095; dst = (float*)(ws + WS_SWM) + (size_t)l * NBATCH * 4096 + n; dpitch = 4096; }
                const float wv[16] = {bflo(w0[q].x), bfhi(w0[q].x), bflo(w0[q].y), bfhi(w0[q].y), bflo(w0[q].z), bfhi(w0[q].z), bflo(w0[q].w), bfhi(w0[q].w), bflo(w1[q].x), bfhi(w1[q].x), bflo(w1[q].y), bfhi(w1[q].y), bflo(w1[q].z), bfhi(w1[q].z), bflo(w1[q].w), bfhi(w1[q].w)};
#pragma unroll
                for (int b = 0; b < NBATCH; ++b) { const float* sh = MOD + ((size_t)l * 4 + b) * 3072; float a = 0.f;
                    const f32x4 a0 = *(const f32x4*)(sh + 8 * lane), a1 = *(const f32x4*)(sh + 8 * lane + 4), a2 = *(const f32x4*)(sh + 512 + 8 * lane), a3 = *(const f32x4*)(sh + 512 + 8 * lane + 4);
                    a += wv[0] * a0.x + wv[1] * a0.y + wv[2] * a0.z + wv[3] * a0.w + wv[4] * a1.x + wv[5] * a1.y + wv[6] * a1.z + wv[7] * a1.w;
                    a += wv[8] * a2.x + wv[9] * a2.y + wv[10] * a2.z + wv[11] * a2.w + wv[12] * a3.x + wv[13] * a3.y + wv[14] * a3.z + wv[15] * a3.w;
                    a = wave_sum(a); if (lane == 0) dst[(size_t)b * dpitch] = a; } }
        }
        { const float* x = kp->x; const float* g = kp->norm_g; bf16* XN = (bf16*)(ws + WS_XN); float* SSQ = (float*)(ws + WS_SSQ);
          for (int m = gwl; m < MROWS; m += NGW) {
              const int b = m >> 13; const f32x4* xr = (const f32x4*)(x + (size_t)m * DM) + lane; f32x4 v[4]; float ss = 0.f;
#pragma unroll
              for (int j = 0; j < 4; ++j) { v[j] = xr[64 * j]; ss += v[j].x * v[j].x + v[j].y * v[j].y + v[j].z * v[j].z + v[j].w * v[j].w; }
              ss = wave_sum(ss); if (lane == 0) *(f32x4*)(SSQ + (size_t)m * 4) = (f32x4){ss, 0.f, 0.f, 0.f};
              u32x2* o8 = (u32x2*)(XN + (size_t)m * DM) + lane;
#pragma unroll
              for (int j = 0; j < 4; ++j) { const int col = 4 * (lane + 64 * j); const f32x4 gg = *(const f32x4*)(g + col), sc = *(const f32x4*)(MOD + (size_t)b * 3072 + 1024 + col);
                  const f32x4 hh = v[j] * gg * (sc + 1.f); u32x2 w; w.x = pk2(hh.x, hh.y); w.y = pk2(hh.z, hh.w); o8[64 * j] = w; } } }
    }
    SEAM(1);

    for (int l = 0; l < DEPTH; ++l) {
        const int pb = 2 + l * PH_PER_LAYER - 1;
        if (IN(pb + 1)) {
            PH_PTRS();
            pg8::PlainOrderT<WGM_G1, MROWS / 256, PW / 256> S{(const char*)(ws + WS_XN), (const char*)(ws + WS_WIN) + (size_t)l * PW * DM * 2, 16, G, (int)blockIdx.x, (size_t)DM, (size_t)DM};
            pg8::EpiP E{(bf16*)(ws + WS_P), (const float*)(ws + WS_SSQ), (const float*)(ws + WS_SW) + (size_t)l * NBATCH * PW, lds + L_GSLOT};
            for (int rep_ = 0; rep_ < NREP(2); ++rep_) { pg8::gemm_phase<pg8::EpiP, pg8::PlainOrderT<WGM_G1, MROWS / 256, PW / 256>, true>(lds, DM, DM, S, E, tid); }
            if (NREP(18) > 1) { pg8::EpiNull EN{(float*)(ws + WS_Y)}; pg8::gemm_phase<pg8::EpiNull, pg8::PlainOrderT<WGM_G1, MROWS / 256, PW / 256>, true>(lds, DM, DM, S, EN, tid); }
        }
        SEAM(pb + 1);
        if (IN(pb + 2)) {
            PH_PTRS();
            const bf16* P = (const bf16*)(ws + WS_P); bf16* Y = (bf16*)(ws + WS_Y); float* U = (float*)(ws + WS_U);
            unsigned* cnts = (unsigned*)(ws + WS_CTL) + CW_CNT + l * 4 * 64; (void)cnts;
            for (int rep_ = 0; rep_ < NREP(3); ++rep_)
            for (int u = blockIdx.x; u < 64; u += G) {
                const int jj = u >> 5, b = (u >> 3) & 3, c0 = (u & 7) * 32, mat = l * 2 + jj, r32 = lane & 31, hi = lane >> 5;
                __syncthreads();
                fa::f32x16 acc[2];
#pragma unroll
                for (int r = 0; r < 16; ++r) { acc[0][r] = 0.f; acc[1][r] = 0.f; }
                const bf16* zrow = P + ((size_t)b * SEQ + (size_t)(c0 + r32) * 32 + 4 * wave) * PW + A_KV + 64 * jj + 8 * hi;
                const bf16* wrow = (const bf16*)(ws + WS_W1T) + ((size_t)mat * 64 + r32) * 2048 + 256 * wave + 8 * hi;
#pragma unroll 4
                for (int ks = 0; ks < 16; ++ks) {
                    const bf16x8 af = *(const bf16x8*)(zrow + (size_t)(ks >> 2) * PW + 16 * (ks & 3));
                    const bf16x8 b0 = *(const bf16x8*)(wrow + 16 * ks), b1 = *(const bf16x8*)(wrow + 32 * 2048 + 16 * ks);
                    acc[0] = __builtin_amdgcn_mfma_f32_32x32x16_bf16(af, b0, acc[0], 0, 0, 0); acc[1] = __builtin_amdgcn_mfma_f32_32x32x16_bf16(af, b1, acc[1], 0, 0, 0); }
                LAS float* red = (LAS float*)lds + wave * 2048;
#pragma unroll
                for (int r = 0; r < 16; ++r) { const int row = fa::crow(r, hi); red[row * 64 + r32] = acc[0][r]; red[row * 64 + 32 + r32] = acc[1][r]; }
                __syncthreads();
                LAS float* hidL = (LAS float*)(lds + 65536);
                const float* b1p = (const float*)(ws + WS_B1P) + mat * 512;
#pragma unroll
                for (int q = 0; q < 4; ++q) { const int idx = tid + 512 * q, e = idx & 63; float sacc = 0.f;
#pragma unroll
                    for (int w = 0; w < 8; ++w) sacc += ((LAS float*)lds)[w * 2048 + idx] + b1p[w * 64 + e];
                    hidL[idx] = siluf_(sacc); }
                __syncthreads();
                LAS float* w2L = (LAS float*)(lds + 65536 + 8192);
                { const float* w2 = kp->cmp_w2 + (size_t)mat * 4096; const f32x4 wa = *(const f32x4*)(w2 + 8 * tid), wb = *(const f32x4*)(w2 + 8 * tid + 4);
                  *(LAS f32x4*)(w2L + 8 * tid) = wa; *(LAS f32x4*)(w2L + 8 * tid + 4) = wb; }
                __syncthreads();
#pragma unroll
                for (int q = 0; q < 2; ++q) { const int idx = tid + 512 * q, row = idx >> 5, e = 2 * (idx & 31); float o0 = 0.f, o1 = 0.f;
#pragma unroll 8
                    for (int d = 0; d < 64; ++d) { const f32x2 w = *(const LAS f32x2*)(w2L + d * 64 + e); const float hv = hidL[row * 64 + d]; o0 += hv * w.x; o1 += hv * w.y; }
                    st_wt((unsigned*)((bf16*)(ws + (jj ? WS_VCB : WS_KCB)) + ((size_t)b * 256 + c0 + row) * 64 + e), pk2(o0, o1)); }
            }
            if (MIX_MERGE) { if (blockIdx.x < 64) publish_count(cnts + 0 * 64, tid == 0); }
            __syncthreads();
            for (int rep_ = 0; rep_ < NREP(4); ++rep_) { if (G > 128) { if ((int)blockIdx.x >= 64) for (int u = (int)blockIdx.x - 64; u < 512; u += G - 64) fa::ustate_unit(P, U, u, lds, tid); } else { for (int u = vcu; u < 512; u += G) fa::ustate_unit(P, U, u, lds, tid); } }
            if (MIX_MERGE) publish_count(cnts + 1 * 64, tid == 0); else __syncthreads();
            const float* sink = kp->sink + l * 4;
            const fa::PreCtx pc{P, (const bf16*)(ws + WS_KCB), (const bf16*)(ws + WS_VCB), (const float*)(ws + WS_U)}; const fa::NextUnit none{fa::K_NONE, 0, false};
            bool pre = false;
            for (int rep_ = 0; rep_ < NREP(5); ++rep_) { for (int u = vcu; u < 512; u += G) { const fa::NextUnit nx = !XPRE ? none : (u + G < 512) ? fa::NextUnit{fa::K_SWA, u + G, false} : fa::NextUnit{fa::K_STICK, vcu, false};
                fa::swa_unit(P, sink, Y, u, lds, tid, pre, nx, pc); pre = XPRE; } }
            for (int rep_ = 0; rep_ < NREP(6); ++rep_) { for (int u = vcu; u < 512; u += G) { const fa::NextUnit nx = !XPRE ? none : (u + G < 512) ? fa::NextUnit{fa::K_STICK, u + G, false} : fa::NextUnit{fa::K_NSA_TOUCH, vcu, false};
                fa::stick_unit(P, Y, u, lds, tid, pre, nx, pc); pre = XPRE && (u + G < 512); } }
        }
        if (!MIX_MERGE) SEAM(pb + 2);
        if (IN(pb + 3)) {
            PH_PTRS();
            float* U = (float*)(ws + WS_U);
            unsigned* cnts = (unsigned*)(ws + WS_CTL) + CW_CNT + l * 4 * 64; (void)cnts;
            if (MIX_MERGE) wait_count(cnts + 1 * 64, (unsigned)G, wave);
            for (int gid = blockIdx.x * NTHREADS + tid; gid < 65536; gid += G * NTHREADS) {
                const int bh = gid >> 12, b = bh >> 2, h = bh & 3, de = gid & 4095;
                const float gch = __expf(logf(1.f - exp2f(-5.f - (float)h)) * 128.f); float r = 0.f;
                float* up = U + (((size_t)b * 64) * 4 + h) * 4096 + de;
                for (int n0 = 0; n0 < 64; n0 += 32) { float uv[32];
#pragma unroll
                    for (int i = 0; i < 32; ++i) uv[i] = up[(size_t)(n0 + i) * 4 * 4096];
#pragma unroll
                    for (int i = 0; i < 32; ++i) { st_wt(up + (size_t)(n0 + i) * 4 * 4096, r); r = r * gch + uv[i]; } }
            }
            if (MIX_MERGE) { publish_count(cnts + 2 * 64, tid == 0); wait_count(cnts + 0 * 64, 64u, wave); } else __syncthreads();
            const fa::PreCtx pc{(const bf16*)(ws + WS_P), (const bf16*)(ws + WS_KCB), (const bf16*)(ws + WS_VCB), (const float*)(ws + WS_U)}; const fa::NextUnit none{fa::K_NONE, 0, false};
            bool pre = false;
            for (int rep_ = 0; rep_ < NREP(7); ++rep_) { for (int u = vcu; u < 512; u += G) { const fa::NextUnit nx = !XPRE ? none : (u + G < 512) ? fa::NextUnit{fa::K_NSA, u + G, false} : fa::NextUnit{fa::K_RET, vcu, false};
                fa::nsa_unit(pc.P, pc.KCB, pc.VCB, (bf16*)(ws + WS_Y), u, lds, tid, pre, nx, pc); pre = XPRE; } }
        }
        if (!MIX_MERGE) SEAM(pb + 3);
        if (IN(pb + 4)) {
            PH_PTRS();
            if (MIX_MERGE) wait_count((unsigned*)(ws + WS_CTL) + CW_CNT + (l * 4 + 2) * 64, (unsigned)G, wave);
            const fa::PreCtx pc{(const bf16*)(ws + WS_P), (const bf16*)(ws + WS_KCB), (const bf16*)(ws + WS_VCB), (const float*)(ws + WS_U)}; const fa::NextUnit none{fa::K_NONE, 0, false};
            bool pre = XPRE;
            for (int rep_ = 0; rep_ < NREP(8); ++rep_) { for (int u = vcu; u < 512; u += G) { const fa::NextUnit nx = (XPRE && u + G < 512) ? fa::NextUnit{fa::K_RET, u + G, true} : none;
                fa::ret_unit(pc.P, pc.R, (bf16*)(ws + WS_Y), u, lds, tid, pre, nx, pc); pre = XPRE && (u + G < 512); } }
        }
        SEAM(pb + 4);
        if (IN(pb + 5)) {
            PH_PTRS();
            pg8::PostOrder S{(const char*)(ws + WS_XN), (const char*)(ws + WS_Y), (const char*)(ws + WS_WCAT) + (size_t)l * 4 * DM * KCAT * 2, G, (int)blockIdx.x};
            pg8::EpiPost E{(bf16*)(ws + WS_MERGED), (u32x4*)(ws + WS_SCR + (size_t)blockIdx.x * 262144), (const float*)(ws + WS_SSQ), (const float*)(ws + WS_SWM) + (size_t)l * NBATCH * 4096, lds + L_GSLOT, tid};
            for (int rep_ = 0; rep_ < NREP(9); ++rep_) { pg8::gemm_phase<pg8::EpiPost, pg8::PostOrder, true>(lds, DM, KCAT, S, E, tid); }
            if (NREP(17) > 1) { pg8::EpiNull EN{(float*)(ws + WS_P + 200 * MiB)}; pg8::gemm_phase<pg8::EpiNull, pg8::PostOrder, true>(lds, DM, KCAT, S, EN, tid); }
        }
        SEAM(pb + 5);
        if (IN(pb + 6)) {
            PH_PTRS();
            pg8::PlainOrderT<WGM_OUT, MROWS / 256, DM / 256> S{(const char*)(ws + WS_MERGED), (const char*)(ws + WS_WO) + (size_t)l * DM * DM * 2, 16, G, (int)blockIdx.x, (size_t)DM, (size_t)DM};
            bf16* XB = (bf16*)((char*)kp->out + 64 * MiB);
            bf16* XF = (bf16*)(ws + WS_XF);
            const float* gate = (const float*)(ws + WS_MOD) + (size_t)l * 4 * 3072 + 2048; const float* gsn = (l + 1 < DEPTH) ? (const float*)(ws + WS_GS) + (size_t)(l + 1) * NBATCH * DM : (const float*)nullptr;
            if (l == 0) { pg8::EpiOutT<false, true> E{kp->x, XB, XB, gate, (bf16*)(ws + WS_XN), gsn, (float*)(ws + WS_SSQ), (LAS float*)(lds + 132096), tid};
                pg8::gemm_phase<pg8::EpiOutT<false, true>, pg8::PlainOrderT<WGM_OUT, MROWS / 256, DM / 256>, true>(lds, DM, DM, S, E, tid); }
            else { pg8::EpiOutT<true, true> E{kp->x, XB, (l + 1 < DEPTH) ? XB : XF, gate, (bf16*)(ws + WS_XN), gsn, (float*)(ws + WS_SSQ), (LAS float*)(lds + 132096), tid};
                pg8::gemm_phase<pg8::EpiOutT<true, true>, pg8::PlainOrderT<WGM_OUT, MROWS / 256, DM / 256>, true>(lds, DM, DM, S, E, tid); }
            if (NREP(19) > 1) { pg8::EpiNull EN{(float*)(ws + WS_P + 200 * MiB)}; pg8::gemm_phase<pg8::EpiNull, pg8::PlainOrderT<WGM_OUT, MROWS / 256, DM / 256>, true>(lds, DM, DM, S, EN, tid); }
        }
        SEAM(pb + 6);
    }
    if (IN(NPH - 1)) {
        PH_PTRS();
        float* out = kp->out; const float* fg = kp->final_g; const bf16* xf = (const bf16*)(ws + WS_XF);
        for (int m = gwl; m < MROWS; m += NGW) {
            const u32x4* xi = (const u32x4*)(xf + (size_t)m * DM) + lane; f32x4 v[4]; float ss = 0.f;
#pragma unroll
            for (int j = 0; j < 2; ++j) { const u32x4 w = xi[64 * j]; v[2 * j] = (f32x4){bflo(w.x), bfhi(w.x), bflo(w.y), bfhi(w.y)}; v[2 * j + 1] = (f32x4){bflo(w.z), bfhi(w.z), bflo(w.w), bfhi(w.w)}; }
#pragma unroll
            for (int j = 0; j < 4; ++j) ss += v[j].x * v[j].x + v[j].y * v[j].y + v[j].z * v[j].z + v[j].w * v[j].w;
            const float r = rsqrtf(wave_sum(ss) * (1.f / DM) + 1e-6f);
#pragma unroll
            for (int j = 0; j < 4; ++j) { const int c4 = 128 * (j >> 1) + 2 * lane + (j & 1); const f32x4 gg = *(const f32x4*)(fg + 4 * c4); *((f32x4*)(out + (size_t)m * DM) + c4) = (v[j] * r) * gg; }
        }
    }
#undef IN
#undef SEAM
}

extern "C" void kernel_launch(void* const* d_in, const int* in_sizes, int n_in, void* d_out, int out_size, void* d_ws, size_t ws_size, hipStream_t stream) {
    static int grid = 0;
    if (grid == 0) {
        if (n_in != 14 || out_size != MROWS * DM || ws_size < WS_END) { fprintf(stderr, "kernel_launch: unexpected problem (n_in %d, out %d, ws %zu)\n", n_in, out_size, ws_size); grid = -1; return; }
        int dev = 0, cus = 0, per_cu = 0;
        if (hipGetDevice(&dev) != hipSuccess || hipDeviceGetAttribute(&cus, hipDeviceAttributeMultiprocessorCount, dev) != hipSuccess) { grid = -1; return; }
        if (hipFuncSetAttribute((const void*)hybrid_fwd, hipFuncAttributeMaxDynamicSharedMemorySize, LDS_BYTES) != hipSuccess) { fprintf(stderr, "kernel_launch: hipFuncSetAttribute failed\n"); grid = -1; return; }
        if (hipOccupancyMaxActiveBlocksPerMultiprocessor(&per_cu, (const void*)hybrid_fwd, NTHREADS, LDS_BYTES) != hipSuccess || per_cu < 1) fprintf(stderr, "kernel_launch: occupancy query reports %d\n", per_cu);
        (void)hipGetLastError();
        grid = cus;
    }
    if (grid < 0) return;
    if (hipMemsetAsync((char*)d_ws + WS_CTL, 0, CTL_ZERO_BYTES, stream) != hipSuccess) return;
    Args a{};
    a.x = (const float*)d_in[0]; a.c = (const float*)d_in[1]; a.w_ada = (const float*)d_in[2]; a.b_ada = (const float*)d_in[3]; a.norm_g = (const float*)d_in[4]; a.w_in = (const float*)d_in[5];
    a.cmp_pos = (const float*)d_in[6]; a.cmp_w1 = (const float*)d_in[7]; a.cmp_w2 = (const float*)d_in[8]; a.sink = (const float*)d_in[9]; a.w_merge = (const float*)d_in[10]; a.w_br = (const float*)d_in[11];
    a.w_out = (const float*)d_in[12]; a.final_g = (const float*)d_in[13];
    a.out = (float*)d_out; a.ws = (unsigned char*)d_ws;
    if (MK_N_LAUNCHES == 1) { a.ph_lo = 0; a.ph_hi = NPH; a.li = 0; hipLaunchKernelGGL(hybrid_fwd, dim3(grid), dim3(NTHREADS), LDS_BYTES, stream, a); }
    else for (int p = 0; p < NPH; ++p) { a.ph_lo = p; a.ph_hi = p + 1; a.li = p; hipLaunchKernelGGL(hybrid_fwd, dim3(grid), dim3(NTHREADS), LDS_BYTES, stream, a); }
}
```

```cpp
#include <hip/hip_runtime.h>
#include <cstdio>
#include <cstdint>

#define GAS __attribute__((address_space(1)))
#define LAS __attribute__((address_space(3)))
typedef unsigned short bf16;
typedef unsigned u32x4 __attribute__((ext_vector_type(4)));
typedef unsigned u32x2 __attribute__((ext_vector_type(2)));
typedef float f32x4 __attribute__((ext_vector_type(4)));
typedef float f32x2 __attribute__((ext_vector_type(2)));
typedef short bf16x8 __attribute__((ext_vector_type(8)));

#ifndef DBG_REP
#define DBG_REP 0
#endif
#define NREP(k) (((DBG_REP >> (k)) & 1) ? 2 : 1)
#ifndef XPRE
#define XPRE (DBG_REP == 0)
#endif
#ifndef WGM_G1
#define WGM_G1 4
#endif
#ifndef GEMM1_SKEW
#define GEMM1_SKEW 4
#endif
#ifndef WGM_POST_V
#define WGM_POST_V 8
#endif
#ifndef WGM_OUT
#define WGM_OUT 8
#endif
#ifndef MIX_MERGE
#define MIX_MERGE 1
#endif
#ifndef MK_N_LAUNCHES
#define MK_N_LAUNCHES 1
#endif

constexpr int DM = 1024, NBATCH = 4, SEQ = 8192, DEPTH = 4, MROWS = NBATCH * SEQ;
constexpr int INW = 3724, PW = 3840;
constexpr int A_Q = 0, A_KV = 256, A_Z = 640, B_Q = 896, B_K = 1152, B_V = 1280, B_Z = 1408;
constexpr int C_Q = 1664, C_K = 1920, C_V = 2176, C_Z = 2432, D_Q = 2688, D_K = 2944, D_V = 3200, D_Z = 3456, A_G = 3712;
constexpr float LOG2E_ = 1.4426950408889634f;
constexpr int KCAT = 1280;
constexpr int NWAVES = 8, NTHREADS = 512;
constexpr int PH_PER_LAYER = 6, NPH = 3 + DEPTH * PH_PER_LAYER;

constexpr size_t MiB = 1u << 20;
constexpr size_t WS_CTL = 0, CTL_ZERO_BYTES = 65536;
constexpr size_t WS_MOD = 1 * MiB;
constexpr size_t WS_KC = 2 * MiB, WS_VC = 2 * MiB + 262144;
constexpr size_t WS_KCB = 2 * MiB + 524288, WS_VCB = 2 * MiB + 655360;
constexpr size_t WS_WIN = 4 * MiB;
constexpr size_t WS_WCAT = 34 * MiB;
constexpr size_t WS_WO = 74 * MiB;
constexpr size_t WS_XN = 82 * MiB;
constexpr size_t WS_Y = 146 * MiB;
constexpr size_t WS_U = 210 * MiB;
constexpr size_t WS_P = 226 * MiB;
constexpr size_t WS_MERGED = WS_P;
constexpr size_t WS_XF = WS_P + 64 * MiB;
constexpr size_t WS_SCR = WS_P + 64 * MiB;
constexpr size_t WS_W1T = 466 * MiB;
constexpr size_t WS_B1P = 3 * MiB;
constexpr size_t WS_GS = 3 * MiB + 65536;
constexpr size_t WS_SW = 3 * MiB + 131072;
constexpr size_t WS_SWM = 3 * MiB + 393216;
constexpr size_t WS_SSQ = 468 * MiB;
constexpr size_t WS_END = 469 * MiB;
constexpr int CW_TMO = 0, CW_BAR = 4096, CW_CNT = 8192;

constexpr int RING_BYTES = 131072;
constexpr int LDSCTL_OFF = RING_BYTES, MISC_OFF = LDSCTL_OFF + 320;
constexpr int LDS_BYTES = 163840;
constexpr int L_GSLOT = 132096, L_EPT = L_GSLOT + 24576;

__device__ __forceinline__ float bf2f(bf16 u) { return __uint_as_float((unsigned)u << 16); }
__device__ __forceinline__ float bflo(unsigned w) { return __uint_as_float(w << 16); }
__device__ __forceinline__ float bfhi(unsigned w) { return __uint_as_float(w & 0xffff0000u); }
__device__ __forceinline__ unsigned f2bf(float f) { unsigned u = __float_as_uint(f); return (u + 0x7fffu + ((u >> 16) & 1u)) >> 16; }
__device__ __forceinline__ unsigned pk2(float lo, float hi) { return f2bf(lo) | (f2bf(hi) << 16); }
typedef __bf16 bf16x2_t __attribute__((ext_vector_type(2)));
__device__ __forceinline__ unsigned cvt_pk_bf16(float lo, float hi) { const f32x2 v = {lo, hi}; const bf16x2_t b = __builtin_convertvector(v, bf16x2_t); return __builtin_bit_cast(unsigned, b); }
template <int M> __device__ __forceinline__ float xshfl(float v) {
    static_assert(M == 1 || M == 2 || M == 4 || M == 8 || M == 16, "xshfl mask");
    if (M == 1) return __uint_as_float(__builtin_amdgcn_update_dpp(0, __float_as_uint(v), 0xB1, 0xF, 0xF, true));
    if (M == 2) return __uint_as_float(__builtin_amdgcn_update_dpp(0, __float_as_uint(v), 0x4E, 0xF, 0xF, true));
    return __uint_as_float(__builtin_amdgcn_ds_swizzle(__float_as_uint(v), (M << 10) | 0x1F));
}
__device__ __forceinline__ float xsum32_(float v) { auto rr = __builtin_amdgcn_permlane32_swap(__float_as_uint(v), __float_as_uint(v), false, false); return __uint_as_float(rr[0]) + __uint_as_float(rr[1]); }
__device__ __forceinline__ float xmax32_(float v) { auto rr = __builtin_amdgcn_permlane32_swap(__float_as_uint(v), __float_as_uint(v), false, false); return fmaxf(__uint_as_float(rr[0]), __uint_as_float(rr[1])); }
__device__ __forceinline__ float wave_sum(float v) { v += xshfl<1>(v); v += xshfl<2>(v); v += xshfl<4>(v); v += xshfl<8>(v); v += xshfl<16>(v); return xsum32_(v); }
__device__ __forceinline__ float wave_max(float v) { v = fmaxf(v, xshfl<1>(v)); v = fmaxf(v, xshfl<2>(v)); v = fmaxf(v, xshfl<4>(v)); v = fmaxf(v, xshfl<8>(v)); v = fmaxf(v, xshfl<16>(v)); return xmax32_(v); }
__device__ __forceinline__ int lane_id_now() { unsigned z = 0u; asm volatile("" : "+v"(z)); return (int)__builtin_amdgcn_mbcnt_hi(~0u, __builtin_amdgcn_mbcnt_lo(~0u, z)); }
__device__ __forceinline__ float sigmoidf_(float x) { return __builtin_amdgcn_rcpf(1.f + __expf(-x)); }
__device__ __forceinline__ float siluf_(float x) { return x * sigmoidf_(x); }
#define LDS_WAIT() asm volatile("s_waitcnt lgkmcnt(0)" ::: "memory")
#define VM_WAIT() asm volatile("s_waitcnt vmcnt(0)" ::: "memory")

__device__ __forceinline__ void publish_count(unsigned* cnt, bool leader) {
    asm volatile("s_waitcnt vmcnt(0)" ::: "memory"); __syncthreads();
    if (leader) (void)__hip_atomic_fetch_add(cnt, 1u, __ATOMIC_RELAXED, __HIP_MEMORY_SCOPE_AGENT);
}
__device__ __forceinline__ void wait_count(unsigned* cnt, unsigned expected, int wave) {
    if (wave == 0) { unsigned spins = 0;
        while ((unsigned)__builtin_amdgcn_readfirstlane((int)__hip_atomic_load(cnt, __ATOMIC_RELAXED, __HIP_MEMORY_SCOPE_AGENT)) < expected) { __builtin_amdgcn_s_sleep(2); if (++spins > (1u << 22)) break; }
        __builtin_amdgcn_fence(__ATOMIC_ACQUIRE, "agent"); asm volatile("s_waitcnt vmcnt(0)" ::: "memory"); }
    __syncthreads();
}
__device__ __forceinline__ void st_wt(float* p, float v) { __hip_atomic_store(p, v, __ATOMIC_RELAXED, __HIP_MEMORY_SCOPE_AGENT); }
__device__ __forceinline__ void st_wt(unsigned* p, unsigned v) { __hip_atomic_store(p, v, __ATOMIC_RELAXED, __HIP_MEMORY_SCOPE_AGENT); }

#define XB_TMO      128
#define XB_XCNT(j)  (256  + 64 * (j))
#define XB_XSUB(j)  (1280 + 64 * (j))
#define XB_XGEN(j)  (2304 + 64 * (j))
#define XB_TOP      3328
#define XB_TOPGEN   3392
#define XCD_BAR_WORDS 3456
#define XB_SPIN_CAP (1u << 18)
__device__ __forceinline__ unsigned xb_ld(unsigned* p)              { return __hip_atomic_load(p, __ATOMIC_RELAXED, __HIP_MEMORY_SCOPE_AGENT); }
__device__ __forceinline__ unsigned xb_add(unsigned* p, unsigned v) { return __hip_atomic_fetch_add(p, v, __ATOMIC_RELAXED, __HIP_MEMORY_SCOPE_AGENT); }
__device__ __forceinline__ unsigned xb_xcc_id() { return (unsigned)__builtin_amdgcn_s_getreg((3 << 11) | 20) & 0xFu; }
#define XB_SPIN(cond, bar) do { unsigned _sp = 0; while (cond) { __builtin_amdgcn_s_sleep(1); \
    if ((++_sp & 255u) == 0u) { if (xb_ld(&(bar)[XB_TMO])) break; if (_sp > XB_SPIN_CAP) { atomicAdd(&(bar)[XB_TMO], 1u); break; } } } } while (0)
struct XcdBarrier { unsigned* bar; unsigned x; volatile LAS unsigned* st; int wave; };
__device__ __forceinline__ XcdBarrier xcd_barrier_post(unsigned* bar, volatile LAS unsigned* st) {
    XcdBarrier b; b.bar = bar; b.x = xb_xcc_id(); b.st = st; b.wave = 0;
    if (threadIdx.x == 0) (void)xb_add(&bar[XB_XCNT(b.x)], 1u);
    return b;
}
__device__ __forceinline__ void xcd_barrier_complete(unsigned* bar, unsigned x, unsigned& nloc, unsigned& nx) {
    const unsigned G = gridDim.x * gridDim.y * gridDim.z;
    unsigned sum, cnt, mine, sp = 0u;
    for (;;) {
        sum = 0u; cnt = 0u; mine = 0u;
#pragma unroll
        for (unsigned j = 0; j < 16; ++j) { const unsigned c = xb_ld(&bar[XB_XCNT(j)]); sum += c; cnt += (c > 0u) ? 1u : 0u; mine = (j == x) ? c : mine; }
        if (sum == G) break;
        __builtin_amdgcn_s_sleep(1);
        if ((++sp & 255u) == 0u) { if (xb_ld(&bar[XB_TMO])) break; if (sp > XB_SPIN_CAP) { atomicAdd(&bar[XB_TMO], 1u); break; } }
    }
    nloc = mine > 0u ? mine : 1u; nx = cnt > 0u ? cnt : 1u;
}
__device__ __forceinline__ void xcd_barrier(const XcdBarrier& b) {
    asm volatile("s_waitcnt vmcnt(0)" ::: "memory");
    __syncthreads();
    if (b.wave == 0 && lane_id_now() == 0) {
        unsigned* bar = b.bar;
        __builtin_amdgcn_s_waitcnt(0);
        unsigned nloc = b.st[0], nx = b.st[1];
        if (nloc == 0u) { xcd_barrier_complete(bar, b.x, nloc, nx); b.st[0] = nloc; b.st[1] = nx; }
        const unsigned old = xb_add(&bar[XB_XSUB(b.x)], 1u);
        const unsigned gen = old / nloc;
        if (old + 1u == (gen + 1u) * nloc) {
            __builtin_amdgcn_fence(__ATOMIC_RELEASE, "agent");
            asm volatile("s_waitcnt vmcnt(0)" ::: "memory");
            const unsigned og = xb_add(&bar[XB_TOP], 1u);
            const unsigned tg = og / nx;
            if (og + 1u == (tg + 1u) * nx) xb_add(&bar[XB_TOPGEN], 1u);
            else XB_SPIN(xb_ld(&bar[XB_TOPGEN]) == tg, bar);
            __builtin_amdgcn_fence(__ATOMIC_ACQUIRE, "agent");
            xb_add(&bar[XB_XGEN(b.x)], 1u);
            asm volatile("s_waitcnt vmcnt(0)" ::: "memory");
        } else {
            XB_SPIN(xb_ld(&bar[XB_XGEN(b.x)]) == gen, bar);
            __builtin_amdgcn_fence(__ATOMIC_ACQUIRE, "agent");
            asm volatile("s_waitcnt vmcnt(0)" ::: "memory");
        }
    }
    __syncthreads();
}

namespace pg8 {
constexpr int BM = 256, BK = 64, HALF = 128, HTB = HALF * BK * 2, STAGE_BYTES = 8 * HTB, NXCD = 8;
__host__ __device__ __forceinline__ int lds_byte(int r, int c) { const int st = (r >> 4) * 2 + (c >> 5), rr = r & 15, cc = c & 31, ob = rr * 64 + cc * 2; return st * 1024 + (ob ^ (((ob >> 9) & 1) << 5)); }
__host__ __device__ __forceinline__ void stage_rc(int b, int& R, int& C) { const int st = b / 1024, sb = b % 1024, swz = sb ^ (((sb >> 9) & 1) << 5); R = (st >> 1) * 16 + swz / 64; C = (st & 1) * 32 + (swz % 64) / 2; }
__host__ __device__ __forceinline__ int perm32(int rho) { const int n = rho >> 4, i = rho & 15; return 8 * (i >> 2) + 4 * n + (i & 3); }

struct Unit { int pm, pn; const char* A; const char* B; int nt; int kind; };

template <int WGM, int nM, int nN> __device__ __forceinline__ void tile_of(int L, int& pm, int& pn) {
    const int nwg = nM * nN; int wgid = L;
    { const int q = nwg / NXCD, r = nwg % NXCD, xcd = wgid % NXCD, off = wgid / NXCD; wgid = (xcd < r ? xcd * (q + 1) : r * (q + 1) + (xcd - r) * q) + off; }
    const int nig = WGM * nN, gid = wgid / nig, fm = gid * WGM, gsz = (nM % WGM == 0) ? WGM : ((nM - fm) < WGM ? (nM - fm) : WGM);
    pm = fm + ((wgid % nig) % gsz); pn = (wgid % nig) / gsz;
}
template <int WGM_, int nM, int nN> struct PlainOrderT {
    const char* A; const char* Bt; int nt, G, c; size_t lda, ldb;
    __device__ __forceinline__ bool next(int i, Unit& u) const {
        const long L = (long)i * G + c; if (L >= (long)nM * nN) return false;
        tile_of<WGM_, nM, nN>((int)L, u.pm, u.pn);
        u.A = A + (size_t)u.pm * BM * lda * 2; u.B = Bt + (size_t)u.pn * BM * ldb * 2; u.nt = nt; u.kind = 0; return true;
    }
};
constexpr int WGM_POST = WGM_POST_V;
struct PostOrder {
    static constexpr int nM = MROWS / 256, nN = DM / 256; const char* XN; const char* Y; const char* Wcat; int G, c;
    __device__ __forceinline__ bool next(int ui, Unit& u) const {
        const int round = ui >> 3, sub = ui & 7, i = sub >> 1, kind = sub & 1;
        const long L = (long)round * G + c; if (L >= (long)nM * nN) return false;
        tile_of<WGM_POST, nM, nN>((int)L, u.pm, u.pn);
        const char* wb = Wcat + ((size_t)i * DM + (size_t)u.pn * BM) * KCAT * 2;
        if (kind == 0) { u.A = XN + (size_t)u.pm * BM * DM * 2; u.B = wb; u.nt = 16; }
        else           { u.A = Y + ((size_t)u.pm * BM * DM + 256 * i) * 2; u.B = wb + 1024 * 2; u.nt = 4; }
        u.kind = sub; return true;
    }
};

__device__ __forceinline__ float row_rstd(const float* ssq, int row) { const f32x4 q = *(const f32x4*)(ssq + (size_t)row * 4); return rsqrtf(((q.x + q.y) + (q.z + q.w)) * (1.f / DM) + 1e-6f); }
struct EpiP {
    static constexpr bool PERM = true; struct Carry {}; static __device__ __forceinline__ bool keeps_acc(int) { return false; }
    bf16* O; const float* ssq; const float* sw; LAS unsigned char* ept_;
    __device__ __forceinline__ void prefetch(const Unit& u, int wid, int ui) const {
        const int ln = lane_id_now(); LAS unsigned char* e = ept_ + (ui & 1) * 8192;
        if (wid < 4) __builtin_amdgcn_global_load_lds((const unsigned*)(ssq + ((size_t)u.pm * BM + wid * 64 + ln) * 4), (LAS unsigned*)(e + wid * 1024), 16, 0, 0);
        else if (wid == 4) __builtin_amdgcn_global_load_lds((const unsigned*)(sw + (size_t)(u.pm >> 5) * PW + u.pn * BM + ln * 4), (LAS unsigned*)(e + 4096), 16, 0, 0);
    }
    __device__ __forceinline__ void operator()(f32x4 (&acc)[2][2][4][2], const Unit& u, int wr, int wc, int fr, int fq, Carry&, int ui) const {
        asm volatile("" : "+v"(fr));
        const LAS unsigned char* ept = ept_ + (ui & 1) * 8192;
        const int row0 = u.pm * BM + wr * 64 + fr, col0 = u.pn * BM + wc * 32 + 8 * fq; const LAS float* swl = (const LAS float*)(ept + 4096) + wc * 32 + 8 * fq;
        const f32x4 s00 = *(const LAS f32x4*)(swl), s01 = *(const LAS f32x4*)(swl + 4), s10 = *(const LAS f32x4*)(swl + HALF), s11 = *(const LAS f32x4*)(swl + HALF + 4);
#pragma unroll
        for (int ai = 0; ai < 2; ++ai)
#pragma unroll
            for (int m = 0; m < 4; ++m) { const int row = row0 + ai * HALF + m * 16; const f32x4 q = *(const LAS f32x4*)(ept + (wr * 64 + fr + ai * HALF + m * 16) * 16);
                const float r = rsqrtf(((q.x + q.y) + (q.z + q.w)) * (1.f / DM) + 1e-6f); bf16* rowp = O + (size_t)row * PW + col0;
#pragma unroll
                for (int bj = 0; bj < 2; ++bj) { const f32x4 v0 = acc[ai][bj][m][0] * r + (bj ? s10 : s00), v1 = acc[ai][bj][m][1] * r + (bj ? s11 : s01);
                    u32x4 w; w.x = cvt_pk_bf16(v0[0], v0[1]); w.y = cvt_pk_bf16(v0[2], v0[3]); w.z = cvt_pk_bf16(v1[0], v1[1]); w.w = cvt_pk_bf16(v1[2], v1[3]);
                    *(u32x4*)(rowp + bj * HALF) = w; } }
    }
};
struct EpiPost {
    static constexpr bool PERM = true;
    static constexpr int NKR = 9, NKL = 3;
    struct Carry { u32x4 k[NKR]; };
    bf16* O; u32x4* scr; const float* ssq; const float* swm; LAS unsigned char* gl_; int tid_;
    static __device__ __forceinline__ bool keeps_acc(int kind) { return (kind & 1) == 0; }
    __device__ __forceinline__ void prefetch(const Unit& u, int wid, int) const {
        if (u.kind & 1) return;
        const int ln = lane_id_now(); LAS unsigned char* ept = gl_ + (L_EPT - L_GSLOT);
        if (wid < 4) __builtin_amdgcn_global_load_lds((const unsigned*)(ssq + ((size_t)u.pm * BM + wid * 64 + ln) * 4), (LAS unsigned*)(ept + wid * 1024), 16, 0, 0);
        else if (wid == 4) __builtin_amdgcn_global_load_lds((const unsigned*)(swm + (size_t)(u.pm >> 5) * 4096 + (u.kind >> 1) * DM + u.pn * BM + ln * 4), (LAS unsigned*)(ept + 4096), 16, 0, 0);
    }
    __device__ __forceinline__ void operator()(f32x4 (&acc)[2][2][4][2], const Unit& u, int wr, int wc, int fr, int fq, Carry& cy, int) const {
        int tid = ((wr * 4 + wc) << 6) | (fq << 4) | fr; const int i = u.kind >> 1;
        asm volatile("" : "+v"(tid), "+v"(fr));
        u32x4* sg = scr + ((tid >> 6) << 10) + (tid & 63);
        LAS u32x4* gl = (LAS u32x4*)(gl_ + tid * 16);
        const int row0 = u.pm * BM + wr * 64 + fr, col0 = u.pn * BM + wc * 32 + 8 * fq;
        u32x4 cin[16 - NKR];
        if ((u.kind & 1) == 0) {
            const LAS unsigned char* ept = gl_ + (L_EPT - L_GSLOT); const LAS float* swb = (const LAS float*)(ept + 4096) + wc * 32 + 8 * fq; const LAS float* sq = (const LAS float*)ept + (wr * 64 + fr) * 4;
            f32x4 q4[4];
#pragma unroll
            for (int k = 0; k < 4; ++k) q4[k] = *(const LAS f32x4*)(sq + k * 64);
            const f32x4 sw0a = *(const LAS f32x4*)(swb) * -LOG2E_, sw0b = *(const LAS f32x4*)(swb + 4) * -LOG2E_, sw1a = *(const LAS f32x4*)(swb + HALF) * -LOG2E_, sw1b = *(const LAS f32x4*)(swb + HALF + 4) * -LOG2E_;
            float rr[4];
#pragma unroll
            for (int sl = 0; sl < 16; ++sl) { const int ai = sl >> 3, bj = (sl >> 2) & 1, m = sl & 3;
                if (sl == 0 || sl == 8) {
#pragma unroll
                    for (int k = 0; k < 4; ++k) rr[k] = -LOG2E_ * rsqrtf(((q4[k].x + q4[k].y) + (q4[k].z + q4[k].w)) * (1.f / DM) + 1e-6f); }
                if (sl == 2) {
#pragma unroll
                    for (int k = 0; k < 4; ++k) q4[k] = *(const LAS f32x4*)(sq + HALF * 4 + k * 64);
#pragma unroll
                    for (int s2 = NKR + NKL; s2 < 16; ++s2) cin[s2 - NKR] = sg[s2 * 64];
                    asm volatile("" ::: "memory"); }
                if (sl >= NKR && sl < NKR + NKL) cin[sl - NKR] = gl[(sl - NKR) * 512];
                const float r = rr[m];
                const f32x4 sa = bj ? sw1a : sw0a, sb = bj ? sw1b : sw0b; const f32x4 v0 = acc[ai][bj][m][0], v1 = acc[ai][bj][m][1];
                const u32x4 pin = (sl < NKR) ? cy.k[sl < NKR ? sl : 0] : cin[sl < NKR ? 0 : sl - NKR]; const u32x4 pq = (i > 0) ? pin : (u32x4){0u, 0u, 0u, 0u};
                float g[8];
                g[0] = fminf(1.f + __builtin_amdgcn_exp2f(v0[0] * r + sa[0]), 0x1p60f); g[1] = fminf(1.f + __builtin_amdgcn_exp2f(v0[1] * r + sa[1]), 0x1p60f); g[2] = fminf(1.f + __builtin_amdgcn_exp2f(v0[2] * r + sa[2]), 0x1p60f); g[3] = fminf(1.f + __builtin_amdgcn_exp2f(v0[3] * r + sa[3]), 0x1p60f);
                g[4] = fminf(1.f + __builtin_amdgcn_exp2f(v1[0] * r + sb[0]), 0x1p60f); g[5] = fminf(1.f + __builtin_amdgcn_exp2f(v1[1] * r + sb[1]), 0x1p60f); g[6] = fminf(1.f + __builtin_amdgcn_exp2f(v1[2] * r + sb[2]), 0x1p60f); g[7] = fminf(1.f + __builtin_amdgcn_exp2f(v1[3] * r + sb[3]), 0x1p60f);
                u32x4 w; w.x = cvt_pk_bf16(g[0], g[1]); w.y = cvt_pk_bf16(g[2], g[3]); w.z = cvt_pk_bf16(g[4], g[5]); w.w = cvt_pk_bf16(g[6], g[7]);
                f32x4 a0, a1;
                a0[0] = bflo(pq.x) * bflo(w.x); a0[1] = bfhi(pq.x) * bfhi(w.x); a0[2] = bflo(pq.y) * bflo(w.y); a0[3] = bfhi(pq.y) * bfhi(w.y);
                a1[0] = bflo(pq.z) * bflo(w.z); a1[1] = bfhi(pq.z) * bfhi(w.z); a1[2] = bflo(pq.w) * bflo(w.w); a1[3] = bfhi(pq.w) * bfhi(w.w);
                acc[ai][bj][m][0] = a0; acc[ai][bj][m][1] = a1;
                if (sl < NKR) cy.k[sl < NKR ? sl : 0] = w; else if (sl < NKR + NKL) gl[(sl - NKR) * 512] = w; else sg[sl * 64] = w; }
        } else {
            bf16* Ob = O + (size_t)row0 * DM + col0;
#pragma unroll
            for (int sl = NKR + NKL; sl < 16; ++sl) cin[sl - NKR] = sg[sl * 64];
#pragma unroll
            for (int sl = NKR; sl < NKR + NKL; ++sl) cin[sl - NKR] = gl[(sl - NKR) * 512];
#pragma unroll
            for (int sl = 0; sl < 16; ++sl) { const int ai = sl >> 3, bj = (sl >> 2) & 1, m = sl & 3; const f32x4 v0 = acc[ai][bj][m][0], v1 = acc[ai][bj][m][1];
                const u32x4 gq = (sl < NKR) ? cy.k[sl < NKR ? sl : 0] : cin[sl < NKR ? 0 : sl - NKR];
                u32x4 w; w.x = cvt_pk_bf16(v0[0] * __builtin_amdgcn_rcpf(bflo(gq.x)), v0[1] * __builtin_amdgcn_rcpf(bfhi(gq.x))); w.y = cvt_pk_bf16(v0[2] * __builtin_amdgcn_rcpf(bflo(gq.y)), v0[3] * __builtin_amdgcn_rcpf(bfhi(gq.y)));
                w.z = cvt_pk_bf16(v1[0] * __builtin_amdgcn_rcpf(bflo(gq.z)), v1[1] * __builtin_amdgcn_rcpf(bfhi(gq.z))); w.w = cvt_pk_bf16(v1[2] * __builtin_amdgcn_rcpf(bflo(gq.w)), v1[3] * __builtin_amdgcn_rcpf(bfhi(gq.w)));
                if (i == 3) *(u32x4*)(Ob + (ai * HALF + m * 16) * DM + bj * HALF) = w;
                else if (sl < NKR) cy.k[sl < NKR ? sl : 0] = w; else if (sl < NKR + NKL) gl[(sl - NKR) * 512] = w; else sg[sl * 64] = w; }
        }
    }
};
template <bool IN_BF, bool OUT_BF>
struct EpiOutT {
    static constexpr bool PERM = true; struct Carry {}; static __device__ __forceinline__ bool keeps_acc(int) { return false; } __device__ __forceinline__ void prefetch(const Unit&, int, int) const {}
    const float* xin; bf16* xb; bf16* xbo; const float* gate; bf16* xg; const float* gs; float* ssq; LAS float* tbl; int tid_;
    __device__ __forceinline__ void operator()(f32x4 (&acc)[2][2][4][2], const Unit& u, int wr, int wc, int fr, int fq, Carry&, int) const {
        const int b = u.pm >> 5; const float* gb = gate + (size_t)b * 3072;
        int tq = ((wr * 4 + wc) << 6) | (fq << 4) | fr; asm volatile("" : "+v"(fr), "+v"(fq), "+v"(tq));
        float ssl[2][4];
#pragma unroll
        for (int ai = 0; ai < 2; ++ai)
#pragma unroll
            for (int m = 0; m < 4; ++m) ssl[ai][m] = 0.f;
#pragma unroll
        for (int bj = 0; bj < 2; ++bj) {
            const int colb = u.pn * BM + bj * HALF + wc * 32 + 8 * fq; const f32x4 g0 = *(const f32x4*)(gb + colb), g1 = *(const f32x4*)(gb + colb + 4);
            f32x4 s0 = (f32x4){0.f, 0.f, 0.f, 0.f}, s1 = s0; if (gs) { s0 = *(const f32x4*)(gs + (size_t)b * DM + colb); s1 = *(const f32x4*)(gs + (size_t)b * DM + colb + 4); }
            u32x4 xw[2][4];
            if (IN_BF) {
#pragma unroll
                for (int ai = 0; ai < 2; ++ai)
#pragma unroll
                    for (int m = 0; m < 4; ++m) xw[ai][m] = *(const u32x4*)(xb + (size_t)(u.pm * BM + ai * HALF + wr * 64 + m * 16 + fr) * DM + colb);
            }
#pragma unroll
            for (int ai = 0; ai < 2; ++ai) {
                f32x4 xo[8];
                if (!IN_BF) {
#pragma unroll
                    for (int q = 0; q < 8; ++q) { const int n = q & 1, m = q >> 1; xo[q] = *(const f32x4*)(xin + (size_t)(u.pm * BM + ai * HALF + wr * 64 + m * 16 + fr) * DM + colb + 4 * n); }
                }
#pragma unroll
                for (int m = 0; m < 4; ++m) { const size_t off = (size_t)(u.pm * BM + ai * HALF + wr * 64 + m * 16 + fr) * DM + colb;
                    f32x4 oa, ob;
                    if (IN_BF) { const u32x4 w = xw[ai][m]; oa = (f32x4){bflo(w.x), bfhi(w.x), bflo(w.y), bfhi(w.y)}; ob = (f32x4){bflo(w.z), bfhi(w.z), bflo(w.w), bfhi(w.w)}; }
                    else { oa = xo[2 * m]; ob = xo[2 * m + 1]; }
                    const f32x4 xa = oa + g0 * acc[ai][bj][m][0], xb_ = ob + g1 * acc[ai][bj][m][1];
                    { u32x4 w; w.x = cvt_pk_bf16(xa.x, xa.y); w.y = cvt_pk_bf16(xa.z, xa.w); w.z = cvt_pk_bf16(xb_.x, xb_.y); w.w = cvt_pk_bf16(xb_.z, xb_.w); *(u32x4*)(xbo + off) = w; }
                    ssl[ai][m] += ((xa.x * xa.x + xa.y * xa.y) + (xa.z * xa.z + xa.w * xa.w)) + ((xb_.x * xb_.x + xb_.y * xb_.y) + (xb_.z * xb_.z + xb_.w * xb_.w));
                    if (gs) { const f32x4 ha = xa * s0, hb = xb_ * s1; u32x4 w; w.x = cvt_pk_bf16(ha.x, ha.y); w.y = cvt_pk_bf16(ha.z, ha.w); w.z = cvt_pk_bf16(hb.x, hb.y); w.w = cvt_pk_bf16(hb.z, hb.w); *(u32x4*)(xg + off) = w; } }
                if (!IN_BF) asm volatile("" ::: "memory");
            }
            asm volatile("" ::: "memory");
        }
#pragma unroll
        for (int ai = 0; ai < 2; ++ai)
#pragma unroll
            for (int m = 0; m < 4; ++m) { float v = ssl[ai][m]; v += xshfl<16>(v); v = xsum32_(v); if (fq == 0) tbl[(ai * HALF + wr * 64 + m * 16 + fr) * 4 + wc] = v; }
        asm volatile("s_waitcnt lgkmcnt(0)" ::: "memory"); __builtin_amdgcn_s_barrier(); asm volatile("" ::: "memory");
        { const int t = tq; if (t < 256) { const f32x4 q = *(const LAS f32x4*)(tbl + t * 4); ssq[(size_t)(u.pm * BM + t) * 4 + u.pn] = (q.x + q.y) + (q.z + q.w); } }
    }
};

struct EpiNull {
    static constexpr bool PERM = true; struct Carry {}; static __device__ __forceinline__ bool keeps_acc(int) { return false; } __device__ __forceinline__ void prefetch(const Unit&, int, int) const {} float* sink;
    __device__ __forceinline__ void operator()(f32x4 (&acc)[2][2][4][2], const Unit& u, int wr, int wc, int fr, int fq, Carry&, int) const {
        f32x4 s = (f32x4){0.f, 0.f, 0.f, 0.f};
#pragma unroll
        for (int a = 0; a < 2; ++a)
#pragma unroll
            for (int b = 0; b < 2; ++b)
#pragma unroll
                for (int m = 0; m < 4; ++m)
#pragma unroll
                    for (int n = 0; n < 2; ++n) s += acc[a][b][m][n];
        if ((s.x + s.y) + (s.z + s.w) == 1.2345e38f) sink[0] = s.x;
    }
};

template <class Epi, class Sched, bool ALIGN_EPI>
__device__ __forceinline__ void gemm_phase(LAS unsigned char* lds, const int lda, const int ldb, const Sched& S, const Epi& E, int tid) {
    asm volatile("" : "+v"(tid));
    const int wid = __builtin_amdgcn_readfirstlane(tid >> 6), lane = tid & 63, wr = wid >> 2, wc = wid & 3, fr = lane & 15, fq = lane >> 4;
    unsigned voffA[2], voffB[2];
#pragma unroll
    for (int i = 0; i < 2; ++i) { int R, C; stage_rc(tid * 16 + i * 8192, R, C); const int Rb = Epi::PERM ? ((R & ~31) + perm32(R & 31)) : R;
        voffA[i] = (unsigned)(R * lda + C) * 2u; voffB[i] = (unsigned)(Rb * ldb + C) * 2u; }
    const size_t kstep = (size_t)(BK * 2);
    const size_t hstepA = (size_t)HALF * lda * 2, hstepB = (size_t)HALF * ldb * 2;
    const unsigned ldsw = (unsigned)wid * 1024u;
    const int aoff = lds_byte(wr * 64 + fr, fq * 8), boff = lds_byte(wc * 32 + fr, fq * 8);
#define PG8_SA(b, h) (((b) * 2 + (h)) * HTB)
#define PG8_SB(b, h) ((4 + (b) * 2 + (h)) * HTB)
#define PG8_STAGE(bufoff, gbase, voff) do { _Pragma("unroll") for (int _i = 0; _i < 2; ++_i) { unsigned vo_ = (voff)[_i]; asm volatile("" : "+v"(vo_));     \
        __builtin_amdgcn_global_load_lds((const unsigned*)((const char*)(gbase) + vo_), (LAS unsigned*)(lds + (bufoff) + ldsw + _i * 8192), 16, 0, 0); } } while (0)
#define PG8_LDA(dst, b, h) do { _Pragma("unroll") for (int m = 0; m < 4; ++m) _Pragma("unroll") for (int k = 0; k < 2; ++k) dst[m][k] = *(const LAS bf16x8*)(lds + PG8_SA(b, h) + aoff + m * 2048 + k * 1024); } while (0)
#define PG8_LDB(dst, b, h) do { _Pragma("unroll") for (int n = 0; n < 2; ++n) _Pragma("unroll") for (int k = 0; k < 2; ++k) dst[n][k] = *(const LAS bf16x8*)(lds + PG8_SB(b, h) + boff + n * 2048 + k * 1024); } while (0)
#define PG8_MMA(ai, bj, At, Bt) do { __builtin_amdgcn_s_setprio(1); _Pragma("unroll") for (int m = 0; m < 4; ++m) _Pragma("unroll") for (int n = 0; n < 2; ++n) _Pragma("unroll") for (int k = 0; k < 2; ++k) \
        acc[ai][bj][m][n] = __builtin_amdgcn_mfma_f32_16x16x32_bf16(Bt[n][k], At[m][k], acc[ai][bj][m][n], 0, 0, 0); __builtin_amdgcn_s_setprio(0); } while (0)
#define PG8_WAIT_V(n) asm volatile("s_waitcnt vmcnt(" #n ")" ::: "memory")
#define PG8_WAIT_L(n) asm volatile("s_waitcnt lgkmcnt(" #n ")" ::: "memory")
#define PG8_BAR __builtin_amdgcn_s_barrier()
#define PG8_SCHED __builtin_amdgcn_sched_barrier(0)
    Unit cur, nxt; int ui = 0;
    if (!S.next(0, cur)) return;
    typename Epi::Carry carry;
    f32x4 acc[2][2][4][2];
#pragma unroll
    for (int a = 0; a < 2; ++a)
#pragma unroll
        for (int b = 0; b < 2; ++b)
#pragma unroll
            for (int m = 0; m < 4; ++m)
#pragma unroll
                for (int n = 0; n < 2; ++n) acc[a][b][m][n] = (f32x4){0.f, 0.f, 0.f, 0.f};
    bf16x8 At[4][2], B0[2][2], B1[2][2];
    const char* cA = cur.A; const char* cB = cur.B;
    PG8_STAGE(PG8_SB(0, 0), cB, voffB); PG8_STAGE(PG8_SB(0, 1), cB + hstepB, voffB); PG8_STAGE(PG8_SA(0, 0), cA, voffA); PG8_STAGE(PG8_SA(0, 1), cA + hstepA, voffA);
    if (wr == 1) PG8_BAR;
    PG8_WAIT_V(2); PG8_BAR;
    PG8_STAGE(PG8_SB(1, 0), cB + kstep, voffB); PG8_STAGE(PG8_SA(1, 0), cA + kstep, voffA); PG8_STAGE(PG8_SB(1, 1), cB + hstepB + kstep, voffB);
    PG8_WAIT_V(6); PG8_BAR;
    for (;;) {
        const bool has_next = S.next(ui + 1, nxt);
        const char* nA = has_next ? nxt.A : cA; const char* nB = has_next ? nxt.B : cB;
        const int nt = cur.nt;
        E.prefetch(cur, wid, ui);
        for (int t = 0; t < nt; t += 2) {
            const bool last = (t == nt - 2);
            const char* a1 = cA + (size_t)(t + 1) * kstep;
            const char* a2 = last ? nA : cA + (size_t)(t + 2) * kstep; const char* b2 = last ? nB : cB + (size_t)(t + 2) * kstep;
            const char* a3 = a2 + kstep; const char* b3 = b2 + kstep;
            PG8_LDB(B0, 0, 0); PG8_LDB(B1, 0, 1); PG8_SCHED; PG8_LDA(At, 0, 0); PG8_STAGE(PG8_SA(1, 1), a1 + hstepA, voffA);
            PG8_WAIT_V(8); PG8_WAIT_L(0); PG8_BAR; PG8_MMA(0, 0, At, B0); PG8_MMA(0, 1, At, B1); PG8_BAR; PG8_SCHED;
            PG8_LDA(At, 0, 1); PG8_STAGE(PG8_SB(0, 0), b2, voffB); PG8_STAGE(PG8_SB(0, 1), b2 + hstepB, voffB); PG8_STAGE(PG8_SA(0, 0), a2, voffA);
            PG8_WAIT_V(8); PG8_WAIT_L(0); PG8_BAR; PG8_MMA(1, 0, At, B0); PG8_MMA(1, 1, At, B1); PG8_BAR; PG8_SCHED;
            PG8_LDB(B0, 1, 0); PG8_LDB(B1, 1, 1); PG8_SCHED; PG8_LDA(At, 1, 0); PG8_STAGE(PG8_SA(0, 1), a2 + hstepA, voffA);
            PG8_WAIT_V(8); PG8_WAIT_L(0); PG8_BAR; PG8_MMA(0, 0, At, B0); PG8_MMA(0, 1, At, B1); PG8_BAR; PG8_SCHED;
            PG8_LDA(At, 1, 1); PG8_STAGE(PG8_SB(1, 0), b3, voffB); PG8_STAGE(PG8_SB(1, 1), b3 + hstepB, voffB); PG8_STAGE(PG8_SA(1, 0), a3, voffA);
            PG8_WAIT_V(8); PG8_WAIT_L(0); PG8_BAR; PG8_MMA(1, 0, At, B0); PG8_MMA(1, 1, At, B1); PG8_BAR; PG8_SCHED;
        }
        if constexpr (ALIGN_EPI) { if (wr == 0) PG8_BAR; }
        { const int ln = lane_id_now(); E(acc, cur, wr, wc, ln & 15, ln >> 4, carry, ui); }
        if (!has_next) break;
        if (!Epi::keeps_acc(cur.kind)) {
#pragma unroll
        for (int a = 0; a < 2; ++a)
#pragma unroll
            for (int b = 0; b < 2; ++b)
#pragma unroll
                for (int m = 0; m < 4; ++m)
#pragma unroll
                    for (int n = 0; n < 2; ++n) acc[a][b][m][n] = (f32x4){0.f, 0.f, 0.f, 0.f};
        }
        cur = nxt; cA = nA; cB = nB; ++ui;
        if constexpr (ALIGN_EPI) { if (wr == 1) PG8_BAR; }
    }
    PG8_WAIT_V(0);
    if constexpr (!ALIGN_EPI) { if (wr == 0) PG8_BAR; }
    PG8_BAR;
#undef PG8_SA
#undef PG8_SB
#undef PG8_STAGE
#undef PG8_LDA
#undef PG8_LDB
#undef PG8_MMA
#undef PG8_WAIT_V
#undef PG8_WAIT_L
#undef PG8_BAR
#undef PG8_SCHED
}
}

struct Args {
    const float* x; const float* c; const float* w_ada; const float* b_ada; const float* norm_g; const float* w_in; const float* cmp_pos; const float* cmp_w1; const float* cmp_w2;
    const float* sink; const float* w_merge; const float* w_br; const float* w_out; const float* final_g;
    float* out; unsigned char* ws; int ph_lo, ph_hi, li, pad;
};

__device__ __forceinline__ int win_src_col(int n) { return n < 640 ? n : (n < 3712 ? n + 12 : (n < 3724 ? n - 3072 : -1)); }
template <bool WINMAP>
__device__ __forceinline__ void transpose_item(const float* W, int spitch, bf16* WT, int dpitch, int dkoff, LAS float* scr, int kb, int nb, int lane) {
    const int k0 = 64 * kb, n0 = 32 * nb;
    int sc = n0 + (lane & 31); if (WINMAP) sc = win_src_col(sc);
    float wv[32];
#pragma unroll
    for (int i = 0; i < 32; ++i) { const int kk = 2 * i + (lane >> 5); wv[i] = sc >= 0 ? W[(size_t)(k0 + kk) * spitch + sc] : 0.f; }
#pragma unroll
    for (int i = 0; i < 32; ++i) { const int kk = 2 * i + (lane >> 5); scr[kk * 33 + (lane & 31)] = wv[i]; }
    LDS_WAIT(); asm volatile("" ::: "memory");
    const int c = lane & 7;
#pragma unroll
    for (int j = 0; j < 4; ++j) { const int n = (lane >> 3) + 8 * j; const LAS float* s = scr + (8 * c) * 33 + n;
        u32x4 o; o.x = pk2(s[0 * 33], s[1 * 33]); o.y = pk2(s[2 * 33], s[3 * 33]); o.z = pk2(s[4 * 33], s[5 * 33]); o.w = pk2(s[6 * 33], s[7 * 33]);
        *(u32x4*)(WT + (size_t)(n0 + n) * dpitch + dkoff + k0 + 8 * c) = o; }
    LDS_WAIT(); asm volatile("" ::: "memory");
}

namespace fa {
typedef float f32x16 __attribute__((ext_vector_type(16)));
typedef short s16x4 __attribute__((ext_vector_type(4)));
typedef short v4i16_t __attribute__((ext_vector_type(4)));
constexpr int SLOT = 16384, L_STG = 65536, L_SEL = 132096, L_UNI = L_SEL + 1024, L_WSF = L_UNI + 64, L_FLG = L_WSF + 2048;
constexpr float LOG2E = 1.4426950408889634f;
__device__ __forceinline__ int crow(int r, int hi) { return (r & 3) + 8 * (r >> 2) + 4 * hi; }
__device__ __forceinline__ float xmax32(float v) { auto rr = __builtin_amdgcn_permlane32_swap(__float_as_uint(v), __float_as_uint(v), false, false); return fmaxf(__uint_as_float(rr[0]), __uint_as_float(rr[1])); }
__device__ __forceinline__ float xsum32(float v) { auto rr = __builtin_amdgcn_permlane32_swap(__float_as_uint(v), __float_as_uint(v), false, false); return __uint_as_float(rr[0]) + __uint_as_float(rr[1]); }
__device__ __forceinline__ void dma_tile(const bf16* k0, const bf16* v0, size_t pitch, LAS unsigned char* slot, int wid, int lane) {
    __builtin_amdgcn_global_load_lds((const unsigned*)(k0 + (size_t)lane * pitch + wid * 8), (LAS unsigned*)(slot + wid * 1024), 16, 0, 0);
    __builtin_amdgcn_global_load_lds((const unsigned*)(v0 + (size_t)(16 * (wid & 3) + (lane >> 2)) * pitch + (wid >> 2) * 32 + (lane & 3) * 8), (LAS unsigned*)(slot + 8192 + wid * 1024), 16, 0, 0);
}
#define FA_WAIT(n) asm volatile("s_waitcnt vmcnt(" #n ") lgkmcnt(0)" ::: "memory")
#define FA_BAR() do { __builtin_amdgcn_s_barrier(); asm volatile("" ::: "memory"); } while (0)
template <class Next, class Issue, class Compute, class Prelude>
__device__ __forceinline__ void tile_stream(int first, Next next, Issue issue, Compute compute, Prelude prelude);
template <class Next, class Issue, class Compute>
__device__ __forceinline__ void tile_stream(int first, Next next, Issue issue, Compute compute) { tile_stream(first, next, issue, compute, []() {}); }
template <class Next, class Issue, class Compute, class Prelude>
__device__ __forceinline__ void tile_stream(int first, Next next, Issue issue, Compute compute, Prelude prelude) {
    int t0 = first, t1 = t0 >= 0 ? next(t0) : -1, t2 = t1 >= 0 ? next(t1) : -1, t3 = t2 >= 0 ? next(t2) : -1, slot = 0;
    if (t0 >= 0) issue(t0, 0);
    if (t1 >= 0) issue(t1, 1);
    if (t2 >= 0) issue(t2, 2);
    prelude();
    while (t0 >= 0) {
        if (t2 >= 0) FA_WAIT(4); else if (t1 >= 0) FA_WAIT(2); else FA_WAIT(0);
        FA_BAR();
        if (t3 >= 0) issue(t3, (slot + 3) & 3);
        compute(t0, slot);
        t0 = t1; t1 = t2; t2 = t3; t3 = t2 >= 0 ? next(t2) : -1; slot = (slot + 1) & 3;
    }
    FA_BAR();
}
template <class Next, class Issue, class Compute>
__device__ __forceinline__ void tile_stream_pair(int first, Next next, Issue issue, Compute compute) {
    int a0 = first, a1 = a0 >= 0 ? next(a0) : -1, par = 0;
    if (a0 >= 0) issue(a0, 0);
    if (a1 >= 0) issue(a1, 1);
    while (a0 >= 0) {
        FA_WAIT(0); FA_BAR();
        const int last = a1 >= 0 ? a1 : a0, n0 = next(last), n1 = n0 >= 0 ? next(n0) : -1;
        if (n0 >= 0) issue(n0, 2 * (par ^ 1));
        if (n1 >= 0) issue(n1, 2 * (par ^ 1) + 1);
        compute(a0, 2 * par);
        if (a1 >= 0) compute(a1, 2 * par + 1);
        a0 = (a1 >= 0) ? n0 : -1; a1 = (a1 >= 0) ? n1 : -1; par ^= 1;
    }
    FA_BAR();
}
__device__ __forceinline__ void qkt(f32x16& p0, f32x16& p1, const LAS unsigned char* kt, const bf16x8 (&qr)[4], int r32, int hi) {
    const LAS unsigned char* kb = kt + hi * 1024 + r32 * 16;
    p0 = (f32x16){0.f, 0.f, 0.f, 0.f, 0.f, 0.f, 0.f, 0.f, 0.f, 0.f, 0.f, 0.f, 0.f, 0.f, 0.f, 0.f}; p1 = p0;
#pragma unroll
    for (int d0 = 0; d0 < 4; ++d0) { const bf16x8 b0 = *(const LAS bf16x8*)(kb + d0 * 2048), b1 = *(const LAS bf16x8*)(kb + d0 * 2048 + 512);
        p0 = __builtin_amdgcn_mfma_f32_32x32x16_bf16(b0, qr[d0], p0, 0, 0, 0); p1 = __builtin_amdgcn_mfma_f32_32x32x16_bf16(b1, qr[d0], p1, 0, 0, 0); }
}
__device__ __forceinline__ s16x4 vtr(const LAS unsigned char* p) { return __builtin_bit_cast(s16x4, __builtin_amdgcn_ds_read_tr16_b64_v4i16((LAS v4i16_t*)p)); }
__device__ __forceinline__ void pv(f32x16 (&o)[2], const LAS unsigned char* vt, const u32x4 (&pw)[4], int lane) {
    const LAS unsigned char* vp = vt + ((lane >> 4) & 1) * 32 + (lane & 3) * 8 + (4 * (lane >> 5) + ((lane & 15) >> 2)) * 64;
#pragma unroll
    for (int d0 = 0; d0 < 2; ++d0)
#pragma unroll
        for (int ks = 0; ks < 4; ++ks) { const s16x4 lo = vtr(vp + d0 * 4096 + ks * 1024), hi4 = vtr(vp + d0 * 4096 + ks * 1024 + 512);
            const bf16x8 vf = (bf16x8){lo[0], lo[1], lo[2], lo[3], hi4[0], hi4[1], hi4[2], hi4[3]};
            o[d0] = __builtin_amdgcn_mfma_f32_32x32x16_bf16(__builtin_bit_cast(bf16x8, pw[ks]), vf, o[d0], 0, 0, 0); }
}
__device__ __forceinline__ void pack_p(u32x4 (&pw)[4], const f32x16& p0, const f32x16& p1) {
    pw[0] = (u32x4){cvt_pk_bf16(p0[0], p0[1]), cvt_pk_bf16(p0[2], p0[3]), cvt_pk_bf16(p0[4], p0[5]), cvt_pk_bf16(p0[6], p0[7])};
    pw[1] = (u32x4){cvt_pk_bf16(p0[8], p0[9]), cvt_pk_bf16(p0[10], p0[11]), cvt_pk_bf16(p0[12], p0[13]), cvt_pk_bf16(p0[14], p0[15])};
    pw[2] = (u32x4){cvt_pk_bf16(p1[0], p1[1]), cvt_pk_bf16(p1[2], p1[3]), cvt_pk_bf16(p1[4], p1[5]), cvt_pk_bf16(p1[6], p1[7])};
    pw[3] = (u32x4){cvt_pk_bf16(p1[8], p1[9]), cvt_pk_bf16(p1[10], p1[11]), cvt_pk_bf16(p1[12], p1[13]), cvt_pk_bf16(p1[14], p1[15])};
}
__device__ __forceinline__ void scale_rows(f32x16 (&o)[2], float f, LAS float* wsf, int r32, int hi) {
    if (hi == 0) wsf[r32] = f;
#pragma unroll
    for (int r = 0; r < 16; ++r) { const float fr = wsf[crow(r, hi)]; o[0][r] *= fr; o[1][r] *= fr; }
}
__device__ __forceinline__ void stage_o(const f32x16 (&o)[2], LAS float* stg, int r32, int hi) {
#pragma unroll
    for (int r = 0; r < 16; ++r) { const int orow = crow(r, hi); stg[orow * 64 + r32] = o[0][r]; stg[orow * 64 + 32 + r32] = o[1][r]; }
}
__device__ __forceinline__ void load_z(u32x4 (&z)[4], const bf16* P, size_t m0, int zcol, int h, int lane) {
#pragma unroll
    for (int i = 0; i < 4; ++i) z[i] = *(const u32x4*)(P + (m0 + i * 8 + (lane >> 3)) * PW + zcol + h * 64 + (lane & 7) * 8);
}
__device__ __forceinline__ void emit_y(const LAS float* stg, const u32x4 (&zz)[4], bf16* Y, size_t m0, int ycol, int h, int lane) {
#pragma unroll
    for (int i = 0; i < 4; ++i) { const int row = i * 8 + (lane >> 3), ch = lane & 7;
        const f32x4 a = *(const LAS f32x4*)(stg + row * 64 + ch * 8), c = *(const LAS f32x4*)(stg + row * 64 + ch * 8 + 4);
        const u32x4 z = zz[i];
        u32x4 w; w.x = cvt_pk_bf16(a.x * siluf_(bflo(z.x)), a.y * siluf_(bfhi(z.x))); w.y = cvt_pk_bf16(a.z * siluf_(bflo(z.y)), a.w * siluf_(bfhi(z.y)));
        w.z = cvt_pk_bf16(c.x * siluf_(bflo(z.z)), c.y * siluf_(bfhi(z.z))); w.w = cvt_pk_bf16(c.z * siluf_(bflo(z.w)), c.w * siluf_(bfhi(z.w)));
        *(u32x4*)(Y + (m0 + row) * DM + ycol + h * 64 + ch * 8) = w; }
}
__device__ __forceinline__ void softmax_step(f32x16& p0, f32x16& p1, float& m, float& l, f32x16 (&o)[2], LAS float* wsf, int r32, int hi) {
    float rm = fmaxf(p0[0], p1[0]);
#pragma unroll
    for (int r = 1; r < 16; ++r) rm = fmaxf(rm, fmaxf(p0[r], p1[r]));
    rm = xmax32(rm);
    const float mn = fmaxf(m, rm), f = __builtin_amdgcn_exp2f(m - mn); m = mn;
    float rs = 0.f;
#pragma unroll
    for (int r = 0; r < 16; ++r) { p0[r] = (p0[r] > -1e29f) ? __builtin_amdgcn_exp2f(p0[r] - mn) : 0.f; p1[r] = (p1[r] > -1e29f) ? __builtin_amdgcn_exp2f(p1[r] - mn) : 0.f; rs += p0[r] + p1[r]; }
    l = l * f + xsum32(rs);
    if (__any(f != 1.f)) scale_rows(o, f, wsf, r32, hi);
}

constexpr int L_DUMMY = L_FLG + 1024;
enum { K_NONE = 0, K_SWA = 1, K_STICK = 2, K_NSA = 3, K_RET = 4, K_NSA_TOUCH = 5 };
struct NextUnit { int kind, unit; bool with_r; };
struct PreCtx { const bf16* P; const bf16* KCB; const bf16* VCB; const float* R; };
__device__ __forceinline__ void touch_line(const void* p, LAS unsigned char* lds, int wid) { __builtin_amdgcn_global_load_lds((const unsigned*)p, (LAS unsigned*)(lds + L_DUMMY + wid * 256), 4, 0, 0); }
__device__ __forceinline__ void swa_first(const bf16* P, int unit, LAS unsigned char* lds, int wid, int lane, bool touch) {
    const int b = unit >> 7, kvh = (unit >> 6) & 1, pos0 = (unit & 63) * 128; const bf16* Pb = P + (size_t)b * SEQ * PW;
    const int jlo = (pos0 >= 127 ? pos0 - 127 : 0) >> 6, jhi = (pos0 + 127) >> 6;
    const bf16* kb = Pb + B_K + kvh * 64; const bf16* vb = Pb + B_V + kvh * 64;
    for (int j = jlo; j <= jhi; ++j) dma_tile(kb + (size_t)(64 * j) * PW, vb + (size_t)(64 * j) * PW, PW, lds + (j - jlo) * SLOT, wid, lane);
    if (touch) { const int idx = wid * 64 + lane, row = idx >> 2, li = idx & 3;
        touch_line((const char*)(Pb + (size_t)(pos0 + row) * PW) + ((li < 2 ? B_Q : B_Z) * 2 + kvh * 256 + (li & 1) * 128), lds, wid); }
}
__device__ __forceinline__ void stick_first(const bf16* P, int unit, LAS unsigned char* lds, int wid, int lane, bool touch) {
    const int b = unit >> 7, h0 = 2 * ((unit >> 6) & 1), pos0 = (unit & 63) * 128, jtop = (pos0 + 126) >> 6; const bf16* Pb = P + (size_t)b * SEQ * PW;
    const bf16* kb = Pb + C_K + h0 * 64; const bf16* vb = Pb + C_V + h0 * 64;
    dma_tile(kb + (size_t)(64 * jtop) * PW, vb + (size_t)(64 * jtop) * PW, PW, lds, wid, lane);
    dma_tile(kb + 64 + (size_t)(64 * jtop) * PW, vb + 64 + (size_t)(64 * jtop) * PW, PW, lds + SLOT, wid, lane);
    if (touch) { const int idx = wid * 64 + lane, row = idx >> 2, li = idx & 3;
        touch_line((const char*)(Pb + (size_t)(pos0 + row) * PW) + ((li < 2 ? C_Q : C_Z) * 2 + h0 * 128 + (li & 1) * 128), lds, wid); }
}
__device__ __forceinline__ void nsa_first(const bf16* P, const bf16* KCB, const bf16* VCB, int unit, LAS unsigned char* lds, int wid, int lane, bool touch, bool tiles) {
    const int b = unit >> 7, pos0 = ((b & 2) ? 127 - (unit & 127) : (unit & 127)) * 64, ncvmax = (pos0 >> 5) + 2, ntile = tiles ? (ncvmax + 63) >> 6 : 0;
    for (int tl = 0; tl < ntile; ++tl) {
        __builtin_amdgcn_global_load_lds((const unsigned*)(KCB + ((size_t)b * 256 + 64 * tl + lane) * 64 + wid * 8), (LAS unsigned*)(lds + tl * 8192 + wid * 1024), 16, 0, 0);
        __builtin_amdgcn_global_load_lds((const unsigned*)(VCB + ((size_t)b * 256 + 64 * tl + 16 * (wid & 3) + (lane >> 2)) * 64 + (wid >> 2) * 32 + (lane & 3) * 8), (LAS unsigned*)(lds + 32768 + tl * 8192 + wid * 1024), 16, 0, 0); }
    if (touch) { const bf16* Pb = P + (size_t)b * SEQ * PW; const int idx = wid * 64 + lane, row = idx >> 3, li = idx & 7;
        touch_line((const char*)(Pb + (size_t)(pos0 + row) * PW) + ((li < 4 ? A_Q : A_Z) * 2 + (li & 3) * 128), lds, wid);
        if (wid == 0) touch_line((const char*)(Pb + (size_t)(pos0 + lane) * PW) + A_G * 2, lds, wid); }
}
__device__ __forceinline__ void ret_first(const bf16* P, const float* R, int unit, LAS unsigned char* lds, int wid, int lane, bool touch, bool with_r) {
    const int b = unit >> 7, h = (unit >> 5) & 3, pos0 = (unit & 31) * 256, j0 = pos0 >> 6; const bf16* Pb = P + (size_t)b * SEQ * PW;
    const bf16* kb = Pb + D_K + h * 64; const bf16* vb = Pb + D_V + h * 64;
#pragma unroll
    for (int tt = 0; tt < 4; ++tt) dma_tile(kb + (size_t)(64 * (j0 + tt)) * PW, vb + (size_t)(64 * (j0 + tt)) * PW, PW, lds + (2 * (tt & 1) + (tt >> 1)) * SLOT, wid, lane);
    if (touch) { const int idx = wid * 64 + lane, row = idx >> 1, li = idx & 1;
        touch_line((const char*)(Pb + (size_t)(pos0 + row) * PW) + ((li ? D_Z : D_Q) * 2 + h * 128), lds, wid);
        if (with_r && wid < 4) { const int n = (pos0 >> 7) + (idx >> 7); touch_line((const char*)(R + ((((size_t)b * 64 + n) * 4 + h) * 64) * 64) + (idx & 127) * 128, lds, wid); } }
}
__device__ __forceinline__ void issue_first(const NextUnit& nx, const PreCtx& pc, LAS unsigned char* lds, int wid, int lane) {
    if (nx.kind == K_SWA) swa_first(pc.P, nx.unit, lds, wid, lane, true);
    else if (nx.kind == K_STICK) stick_first(pc.P, nx.unit, lds, wid, lane, true);
    else if (nx.kind == K_NSA) nsa_first(pc.P, pc.KCB, pc.VCB, nx.unit, lds, wid, lane, true, true);
    else if (nx.kind == K_NSA_TOUCH) nsa_first(pc.P, pc.KCB, pc.VCB, nx.unit, lds, wid, lane, true, false);
    else if (nx.kind == K_RET) ret_first(pc.P, pc.R, nx.unit, lds, wid, lane, true, nx.with_r);
}
__device__ __forceinline__ void swa_unit(const bf16* P, const float* sink4, bf16* Y, int unit, LAS unsigned char* lds, int tid, bool pre, const NextUnit& nx, const PreCtx& pc) {
    asm volatile("" : "+v"(tid));
    const int lane = tid & 63, wid = __builtin_amdgcn_readfirstlane(tid >> 6), r32 = lane & 31, hi = lane >> 5;
    const int b = unit >> 7, kvh = (unit >> 6) & 1, pos0 = (unit & 63) * 128, h = 2 * kvh + (wid & 1), tw0 = pos0 + 32 * (wid >> 1), t = tw0 + r32;
    const bf16* Pb = P + (size_t)b * SEQ * PW;
    bf16x8 qr[4];
#pragma unroll
    for (int d0 = 0; d0 < 4; ++d0) qr[d0] = *(const bf16x8*)(Pb + (size_t)t * PW + B_Q + h * 64 + d0 * 16 + hi * 8);
    const float slope2 = exp2f(-2.f * (float)(h + 1)) * LOG2E, scale2 = 0.125f * LOG2E;
    u32x4 zz[4]; load_z(zz, P, (size_t)b * SEQ + tw0, B_Z, h, lane);
    float m = sink4[h] * LOG2E, l = 1.f; f32x16 o[2];
#pragma unroll
    for (int r = 0; r < 16; ++r) { o[0][r] = 0.f; o[1][r] = 0.f; }
    LAS float* wsf = (LAS float*)(lds + L_WSF) + wid * 64; LAS float* stg = (LAS float*)(lds + L_STG) + wid * 2048;
    const int jlo = (pos0 >= 127 ? pos0 - 127 : 0) >> 6, jhi = (pos0 + 127) >> 6;
    const bf16* kb = Pb + B_K + kvh * 64; const bf16* vb = Pb + B_V + kvh * 64;
    if (!pre) for (int j = jlo; j <= jhi; ++j) dma_tile(kb + (size_t)(64 * j) * PW, vb + (size_t)(64 * j) * PW, PW, lds + (j - jlo) * SLOT, wid, lane);
    FA_WAIT(0); FA_BAR();
    for (int j = jlo; j <= jhi; ++j) {
        if (64 * j + 63 >= tw0 - 127 && 64 * j <= tw0 + 31) {
            const LAS unsigned char* kt = lds + (j - jlo) * SLOT;
            f32x16 p0, p1; qkt(p0, p1, kt, qr, r32, hi);
            const int d0 = t - (64 * j + 4 * hi);
#pragma unroll
            for (int r = 0; r < 16; ++r) { const int d = d0 - ((r & 3) + 8 * (r >> 2)), e = d - 32;
                p0[r] = (d >= 0 && d < 128) ? p0[r] * scale2 - slope2 * (float)d : -1e30f; p1[r] = (e >= 0 && e < 128) ? p1[r] * scale2 - slope2 * (float)e : -1e30f; }
            softmax_step(p0, p1, m, l, o, wsf, r32, hi);
            u32x4 pw[4]; pack_p(pw, p0, p1); pv(o, kt + 8192, pw, lane);
        }
    }
    FA_BAR();
    issue_first(nx, pc, lds, wid, lane);
    scale_rows(o, 1.f / l, wsf, r32, hi);
    stage_o(o, stg, r32, hi);
    emit_y(stg, zz, Y, (size_t)b * SEQ + tw0, 256, h, lane);
}
__device__ __forceinline__ void stick_unit(const bf16* P, bf16* Y, int unit, LAS unsigned char* lds, int tid, bool pre, const NextUnit& nx, const PreCtx& pc) {
    asm volatile("" : "+v"(tid));
    const int lane = tid & 63, wid = __builtin_amdgcn_readfirstlane(tid >> 6), r32 = lane & 31, hi = lane >> 5;
    const int b = unit >> 7, hs = wid >> 2, h = 2 * ((unit >> 6) & 1) + hs, pos0 = (unit & 63) * 128, tw0 = pos0 + 32 * (wid & 3), t = tw0 + r32;
    const bf16* Pb = P + (size_t)b * SEQ * PW;
    bf16x8 qr[4];
#pragma unroll
    for (int d0 = 0; d0 < 4; ++d0) qr[d0] = *(const bf16x8*)(Pb + (size_t)t * PW + C_Q + h * 64 + d0 * 16 + hi * 8);
    u32x4 zz[4]; load_z(zz, P, (size_t)b * SEQ + tw0, C_Z, h, lane);
    float carry = 1.f; f32x16 o[2];
#pragma unroll
    for (int r = 0; r < 16; ++r) { o[0][r] = 0.f; o[1][r] = 0.f; }
    LAS float* stg = (LAS float*)(lds + L_STG) + wid * 2048; volatile LAS unsigned* flags = (volatile LAS unsigned*)(lds + L_FLG);
    const int jtop = (pos0 + 126) >> 6, h0 = 2 * ((unit >> 6) & 1);
    if (lane == 0) { flags[wid] = 0u; flags[8 + wid] = 0u; }
    const bf16* kb = Pb + C_K + h0 * 64; const bf16* vb = Pb + C_V + h0 * 64;
#define STK_ISSUE(j, pr) do { dma_tile(kb + (size_t)(64 * (j)) * PW, vb + (size_t)(64 * (j)) * PW, PW, lds + (2 * (pr)) * SLOT, wid, lane); \
                              dma_tile(kb + 64 + (size_t)(64 * (j)) * PW, vb + 64 + (size_t)(64 * (j)) * PW, PW, lds + (2 * (pr) + 1) * SLOT, wid, lane); } while (0)
    int t0 = jtop, it = 0; bool done = false;
    if (!pre) STK_ISSUE(jtop, 0);
    while (t0 >= 0) {
        FA_WAIT(0);
        FA_BAR();
        { unsigned nd = 0; const volatile LAS unsigned* fl = flags + (it & 1) * 8;
#pragma unroll
          for (int w = 0; w < 8; ++w) nd += fl[w];
          if (__builtin_amdgcn_readfirstlane(nd) == 8u) break; }
        if (t0 >= 1) STK_ISSUE(t0 - 1, (it + 1) & 1);
        const int j = t0; const LAS unsigned char* kt = lds + (2 * (it & 1) + hs) * SLOT;
        if (!done && 64 * j <= tw0 + 30) {
            f32x16 p0, p1, s0, s1; qkt(p0, p1, kt, qr, r32, hi);
            const int d0 = t - (64 * j + 4 * hi);
            constexpr float NC = -0.125f * LOG2E;
            if (64 * j + 63 < tw0) {
#pragma unroll
                for (int r = 0; r < 16; ++r) { const float b0 = __builtin_amdgcn_rcpf(1.f + __builtin_amdgcn_exp2f(p0[r] * NC)), b1 = __builtin_amdgcn_rcpf(1.f + __builtin_amdgcn_exp2f(p1[r] * NC));
                    p0[r] = b0; p1[r] = b1; s0[r] = 1.f - b0; s1[r] = 1.f - b1; }
            } else {
#pragma unroll
            for (int r = 0; r < 16; ++r) { const int d = d0 - ((r & 3) + 8 * (r >> 2)), e = d - 32;
                const float b0 = (d >= 1) ? __builtin_amdgcn_rcpf(1.f + __builtin_amdgcn_exp2f(p0[r] * NC)) : 0.f, b1 = (e >= 1) ? __builtin_amdgcn_rcpf(1.f + __builtin_amdgcn_exp2f(p1[r] * NC)) : 0.f;
                p0[r] = b0; p1[r] = b1; s0[r] = 1.f - b0; s1[r] = 1.f - b1; }
            }
            float T[8], PT[8], after[8];
#pragma unroll
            for (int k = 0; k < 4; ++k) { T[k] = (s0[4 * k] * s0[4 * k + 1]) * (s0[4 * k + 2] * s0[4 * k + 3]); T[4 + k] = (s1[4 * k] * s1[4 * k + 1]) * (s1[4 * k + 2] * s1[4 * k + 3]); }
#pragma unroll
            for (int k = 0; k < 8; ++k) { auto rr = __builtin_amdgcn_permlane32_swap(__float_as_uint(T[k]), __float_as_uint(T[k]), false, false); PT[k] = __uint_as_float(hi ? rr[0] : rr[1]); }
            float aT = 1.f, aP = 1.f;
#pragma unroll
            for (int k = 7; k >= 0; --k) { after[k] = aT * (hi ? aP : aP * PT[k]); aT *= T[k]; aP *= PT[k]; }
#pragma unroll
            for (int k = 0; k < 4; ++k) { float run0 = after[k] * carry, run1 = after[4 + k] * carry;
#pragma unroll
                for (int e = 3; e >= 0; --e) { const int r = 4 * k + e;
                    const float w0 = p0[r] * run0, w1 = p1[r] * run1;
                    run0 *= s0[r]; run1 *= s1[r]; p0[r] = w0; p1[r] = w1; } }
            carry *= aT * aP;
            u32x4 pw[4]; pack_p(pw, p0, p1); pv(o, kt + 8192, pw, lane);
            done = __all(carry == 0.f);
        }
        if (lane == 0) flags[((it + 1) & 1) * 8 + wid] = (done || j == 0) ? 1u : 0u;
        --t0; ++it;
    }
#undef STK_ISSUE
    FA_WAIT(0); FA_BAR();
    issue_first(nx, pc, lds, wid, lane);
    stage_o(o, stg, r32, hi);
    emit_y(stg, zz, Y, (size_t)b * SEQ + tw0, 512, h, lane);
}
__device__ __forceinline__ void ret_unit(const bf16* P, const float* R, bf16* Y, int unit, LAS unsigned char* lds, int tid, bool pre, const NextUnit& nx, const PreCtx& pc) {
    asm volatile("" : "+v"(tid));
    const int lane = tid & 63, wid = __builtin_amdgcn_readfirstlane(tid >> 6), r32 = lane & 31, hi = lane >> 5;
    const int b = unit >> 7, h = (unit >> 5) & 3, pos0 = (unit & 31) * 256, ch = wid >> 2, n = (pos0 >> 7) + ch, i0 = 32 * (wid & 3), i = i0 + r32, tw0 = pos0 + 128 * ch + i0;
    const bf16* Pb = P + (size_t)b * SEQ * PW;
    bf16x8 qr[4];
#pragma unroll
    for (int d0 = 0; d0 < 4; ++d0) qr[d0] = *(const bf16x8*)(Pb + (size_t)(tw0 + r32) * PW + D_Q + h * 64 + d0 * 16 + hi * 8);
    const float lg2 = __builtin_amdgcn_logf(1.f - exp2f(-5.f - (float)h));
    u32x4 zz[4]; load_z(zz, P, (size_t)b * SEQ + tw0, D_Z, h, lane);
    float cG[16]; const float g32 = __builtin_amdgcn_exp2f(lg2 * -32.f);
#pragma unroll
    for (int r = 0; r < 16; ++r) cG[r] = __builtin_amdgcn_exp2f(-lg2 * (float)((r & 3) + 8 * (r >> 2)));
    f32x16 o[2], o2[2];
#pragma unroll
    for (int r = 0; r < 16; ++r) { o[0][r] = 0.f; o[1][r] = 0.f; o2[0][r] = 0.f; o2[1][r] = 0.f; }
    LAS float* wsf = (LAS float*)(lds + L_WSF) + wid * 64; LAS float* stg = (LAS float*)(lds + L_STG) + wid * 2048;
    const int j0 = pos0 >> 6;
    const bf16* kb = Pb + D_K + h * 64; const bf16* vb = Pb + D_V + h * 64;
    if (!pre) {
#pragma unroll
    for (int tt = 0; tt < 4; ++tt) dma_tile(kb + (size_t)(64 * (j0 + tt)) * PW, vb + (size_t)(64 * (j0 + tt)) * PW, PW, lds + (2 * (tt & 1) + (tt >> 1)) * SLOT, wid, lane);
    }
    { const float* Rn = R + ((((size_t)b * 64 + n) * 4 + h) * 64) * 64;
#pragma unroll
      for (int d0 = 0; d0 < 4; ++d0)
#pragma unroll
          for (int eh = 0; eh < 2; ++eh) { const float* rp = Rn + (size_t)(16 * d0 + 8 * hi) * 64 + 32 * eh + r32;
              u32x4 w; w.x = cvt_pk_bf16(rp[0], rp[64]); w.y = cvt_pk_bf16(rp[128], rp[192]); w.z = cvt_pk_bf16(rp[256], rp[320]); w.w = cvt_pk_bf16(rp[384], rp[448]);
              o2[eh] = __builtin_amdgcn_mfma_f32_32x32x16_bf16(qr[d0], __builtin_bit_cast(bf16x8, w), o2[eh], 0, 0, 0); } }
    FA_WAIT(0); FA_BAR();
#pragma unroll
    for (int tl = 0; tl < 2; ++tl) {
        if (64 * tl <= i0 + 31) {
            const LAS unsigned char* kt = lds + (2 * tl + ch) * SLOT;
            f32x16 p0, p1; qkt(p0, p1, kt, qr, r32, hi);
            const int d0 = i - (64 * tl + 4 * hi);
            const float rf0 = 0.125f * __builtin_amdgcn_exp2f(lg2 * (float)d0), rf1 = rf0 * g32;
            if (64 * tl + 63 <= i0) {
#pragma unroll
                for (int r = 0; r < 16; ++r) { p0[r] = p0[r] * rf0 * cG[r]; p1[r] = p1[r] * rf1 * cG[r]; }
            } else {
#pragma unroll
                for (int r = 0; r < 16; ++r) { const int d = d0 - ((r & 3) + 8 * (r >> 2)), e = d - 32;
                    p0[r] = (d >= 0) ? p0[r] * rf0 * cG[r] : 0.f; p1[r] = (e >= 0) ? p1[r] * rf1 * cG[r] : 0.f; }
            }
            u32x4 pw[4]; pack_p(pw, p0, p1); pv(o, kt + 8192, pw, lane);
        }
    }
    FA_BAR();
    issue_first(nx, pc, lds, wid, lane);
    scale_rows(o2, 0.125f * __builtin_amdgcn_exp2f(lg2 * (float)(i + 1)), wsf, r32, hi);
#pragma unroll
    for (int r = 0; r < 16; ++r) { o[0][r] += o2[0][r]; o[1][r] += o2[1][r]; }
    stage_o(o, stg, r32, hi);
    { const size_t m0 = (size_t)b * SEQ + tw0;
#pragma unroll
      for (int it = 0; it < 4; ++it) { const int row = it * 8 + (lane >> 3), c8 = lane & 7;
          const f32x4 a = *(const LAS f32x4*)(stg + row * 64 + c8 * 8), c = *(const LAS f32x4*)(stg + row * 64 + c8 * 8 + 4);
          float sm = (a.x + a.y) + (a.z + a.w) + (c.x + c.y) + (c.z + c.w);
          sm += xshfl<1>(sm); sm += xshfl<2>(sm); sm += xshfl<4>(sm);
          const float mu = sm * (1.f / 64.f); const f32x4 da = a - mu, dc = c - mu;
          float vs = (da.x * da.x + da.y * da.y) + (da.z * da.z + da.w * da.w) + (dc.x * dc.x + dc.y * dc.y) + (dc.z * dc.z + dc.w * dc.w);
          vs += xshfl<1>(vs); vs += xshfl<2>(vs); vs += xshfl<4>(vs);
          const float rs = rsqrtf(vs * (1.f / 64.f) + 1e-5f);
          const u32x4 z = zz[it];
          u32x4 w; w.x = cvt_pk_bf16(da.x * rs * siluf_(bflo(z.x)), da.y * rs * siluf_(bfhi(z.x))); w.y = cvt_pk_bf16(da.z * rs * siluf_(bflo(z.y)), da.w * rs * siluf_(bfhi(z.y)));
          w.z = cvt_pk_bf16(dc.x * rs * siluf_(bflo(z.z)), dc.y * rs * siluf_(bfhi(z.z))); w.w = cvt_pk_bf16(dc.z * rs * siluf_(bflo(z.w)), dc.w * rs * siluf_(bfhi(z.w)));
          *(u32x4*)(Y + (m0 + row) * DM + 768 + h * 64 + c8 * 8) = w; } }
}
__device__ __forceinline__ void nsa_unit(const bf16* P, const bf16* KCB, const bf16* VCB, bf16* Y, int unit, LAS unsigned char* lds, int tid, bool pre, const NextUnit& nx, const PreCtx& pc) {
    asm volatile("" : "+v"(tid));
    const int lane = tid & 63, wid = __builtin_amdgcn_readfirstlane(tid >> 6), r32 = lane & 31, hi = lane >> 5;
    const int b = unit >> 7, pos0 = ((b & 2) ? 127 - (unit & 127) : (unit & 127)) * 64, cur = pos0 >> 6;
    const bf16* Pb = P + (size_t)b * SEQ * PW;
    LAS float* OA = (LAS float*)(lds + L_STG); LAS unsigned* selm = (LAS unsigned*)(lds + L_SEL); LAS unsigned* uni = (LAS unsigned*)(lds + L_UNI); LAS float* wsf = (LAS float*)(lds + L_WSF) + wid * 64;
    LAS float* stg = OA + wid * 2048;
    const float scale2 = 0.125f * LOG2E;
    const int pl = r32 >> 2, h = r32 & 3, t = pos0 + 8 * wid + pl;
    const float slope2 = exp2f(-2.f * (float)(h + 1)) * LOG2E;
    bf16x8 qr[4];
#pragma unroll
    for (int d0 = 0; d0 < 4; ++d0) qr[d0] = *(const bf16x8*)(Pb + (size_t)t * PW + A_Q + h * 64 + d0 * 16 + hi * 8);
    const bf16 gl0 = Pb[(size_t)t * PW + A_G + 3 * h], gl1 = Pb[(size_t)t * PW + A_G + 3 * h + 1], gl2 = Pb[(size_t)t * PW + A_G + 3 * h + 2];
    u32x4 zz[4];
#pragma unroll
    for (int it = 0; it < 4; ++it) { const int row = 32 * wid + it * 8 + (lane >> 3); zz[it] = *(const u32x4*)(Pb + (size_t)(pos0 + (row >> 2)) * PW + A_Z + (row & 3) * 64 + (lane & 7) * 8); }
    for (int rep1_ = 0; rep1_ < NREP(10); ++rep1_) {
        const int ncvmax = (pos0 >> 5) + 2, ntile = (ncvmax + 63) >> 6;
        if (tid < 4) uni[tid] = 0u;
        if (!(pre && rep1_ == 0))
        for (int tl = 0; tl < ntile; ++tl) {
            __builtin_amdgcn_global_load_lds((const unsigned*)(KCB + ((size_t)b * 256 + 64 * tl + lane) * 64 + wid * 8), (LAS unsigned*)(lds + tl * 8192 + wid * 1024), 16, 0, 0);
            __builtin_amdgcn_global_load_lds((const unsigned*)(VCB + ((size_t)b * 256 + 64 * tl + 16 * (wid & 3) + (lane >> 2)) * 64 + (wid >> 2) * 32 + (lane & 3) * 8), (LAS unsigned*)(lds + 32768 + tl * 8192 + wid * 1024), 16, 0, 0); }
        FA_WAIT(0); FA_BAR();
        const int ncv = (t >= 31) ? (((t - 31) >> 5) + 1) : 0;
        float m = -1e30f, l = 0.f;
        for (int tl = 0; tl < ntile; ++tl) {
            f32x16 p0, p1; qkt(p0, p1, lds + tl * 8192, qr, r32, hi);
            const int c0 = 64 * tl + 4 * hi; float rm = -1e30f;
#pragma unroll
            for (int r = 0; r < 16; ++r) { const int c = c0 + (r & 3) + 8 * (r >> 2);
                p0[r] = (c < ncv) ? p0[r] * scale2 - slope2 * (float)(t - 32 * c - 31) : -1e30f; p1[r] = (c + 32 < ncv) ? p1[r] * scale2 - slope2 * (float)(t - 32 * (c + 32) - 31) : -1e30f;
                rm = fmaxf(rm, fmaxf(p0[r], p1[r])); }
            rm = xmax32(rm); const float mn = fmaxf(m, rm); float rs = 0.f;
#pragma unroll
            for (int r = 0; r < 16; ++r) { rs += (p0[r] > -1e29f ? __builtin_amdgcn_exp2f(p0[r] - mn) : 0.f) + (p1[r] > -1e29f ? __builtin_amdgcn_exp2f(p1[r] - mn) : 0.f); }
            l = l * __builtin_amdgcn_exp2f(m - mn) + xsum32(rs); m = mn;
        }
        const float inv = l > 0.f ? 1.f / l : 0.f;
        f32x16 o[2];
#pragma unroll
        for (int r = 0; r < 16; ++r) { o[0][r] = 0.f; o[1][r] = 0.f; }
        LAS float* impw = stg;
        for (int tl = 0; tl < ntile; ++tl) {
            f32x16 p0, p1; qkt(p0, p1, lds + tl * 8192, qr, r32, hi);
            const int c0 = 64 * tl + 4 * hi;
#pragma unroll
            for (int r = 0; r < 16; ++r) { const int c = c0 + (r & 3) + 8 * (r >> 2);
                p0[r] = (c < ncv) ? __builtin_amdgcn_exp2f(p0[r] * scale2 - slope2 * (float)(t - 32 * c - 31) - m) * inv : 0.f;
                p1[r] = (c + 32 < ncv) ? __builtin_amdgcn_exp2f(p1[r] * scale2 - slope2 * (float)(t - 32 * (c + 32) - 31) - m) * inv : 0.f; }
#pragma unroll
            for (int r = 0; r < 16; r += 2) { float a0 = p0[r] + p0[r + 1], a1 = p1[r] + p1[r + 1];
                a0 += xshfl<1>(a0); a0 += xshfl<2>(a0); a1 += xshfl<1>(a1); a1 += xshfl<2>(a1);
                const int jl = ((r & 3) >> 1) + 4 * (r >> 2) + 2 * hi;
                if (h == 0) { impw[pl * 128 + 32 * tl + jl] = a0; impw[pl * 128 + 32 * tl + 16 + jl] = a1; } }
            u32x4 pw[4]; pack_p(pw, p0, p1); pv(o, lds + 32768 + tl * 8192, pw, lane);
        }
        { const int pq = lane >> 3, sub = lane & 7; unsigned bits = 0u;
          if (cur <= 15) {
#pragma unroll
              for (int c = 0; c < 16; ++c) bits |= (sub * 16 + c <= cur) ? (1u << c) : 0u;
          } else {
              float cand[16]; const int kend = cur - 2;
#pragma unroll
              for (int c = 0; c < 16; ++c) { const int jc = sub * 16 + c; cand[c] = (jc >= 1 && jc <= kend) ? impw[pq * 128 + jc] : -1.f;
                  bits |= ((jc == 0) || (jc == cur) || (jc == cur - 1)) ? (1u << c) : 0u; }
              for (int round = 0; round < 13; ++round) {
                  float vm = cand[0];
#pragma unroll
                  for (int c = 1; c < 16; ++c) vm = fmaxf(vm, cand[c]);
                  vm = fmaxf(vm, __uint_as_float(__builtin_amdgcn_update_dpp(0, __float_as_uint(vm), 0xB1, 0xF, 0xF, true)));
                  vm = fmaxf(vm, __uint_as_float(__builtin_amdgcn_update_dpp(0, __float_as_uint(vm), 0x4E, 0xF, 0xF, true)));
                  vm = fmaxf(vm, __uint_as_float(__builtin_amdgcn_update_dpp(0, __float_as_uint(vm), 0x141, 0xF, 0xF, true)));
                  int idx = 255;
#pragma unroll
                  for (int c = 15; c >= 0; --c) idx = (cand[c] == vm) ? sub * 16 + c : idx;
                  idx = min(idx, (int)__builtin_amdgcn_update_dpp(0, (unsigned)idx, 0xB1, 0xF, 0xF, true));
                  idx = min(idx, (int)__builtin_amdgcn_update_dpp(0, (unsigned)idx, 0x4E, 0xF, 0xF, true));
                  idx = min(idx, (int)__builtin_amdgcn_update_dpp(0, (unsigned)idx, 0x141, 0xF, 0xF, true));
#pragma unroll
                  for (int c = 0; c < 16; ++c) { const bool hit = (sub * 16 + c == idx) && (vm >= 0.f); bits |= hit ? (1u << c) : 0u; cand[c] = hit ? -1.f : cand[c]; }
              }
          }
          ((LAS unsigned short*)selm)[(8 * wid + pq) * 8 + sub] = (unsigned short)bits;
          (void)__hip_atomic_fetch_or(uni + (sub >> 1), bits << (16 * (sub & 1)), __ATOMIC_RELAXED, __HIP_MEMORY_SCOPE_WORKGROUP); }
        const float g0 = sigmoidf_(bf2f(gl0));
        scale_rows(o, g0, wsf, r32, hi);
        stage_o(o, stg, r32, hi);
    }
    FA_WAIT(0); FA_BAR();
    {
        unsigned selw[4], un[4];
#pragma unroll
        for (int i = 0; i < 4; ++i) { selw[i] = selm[(8 * wid + pl) * 4 + i]; un[i] = __builtin_amdgcn_readfirstlane(uni[i]); }
        const float g1 = sigmoidf_(bf2f(gl1)), g2 = sigmoidf_(bf2f(gl2));
        float cK[16];
#pragma unroll
        for (int r = 0; r < 16; ++r) cK[r] = slope2 * (float)((r & 3) + 8 * (r >> 2));
        for (int rep2_ = 0; rep2_ < NREP(11); ++rep2_)
        for (int br = 0; br < 2; ++br) {
            const bf16* kb = Pb + A_KV + (br ? 256 : 128); const bf16* vb = kb + 64;
            float m = -1e30f, l = 0.f; f32x16 o[2];
#pragma unroll
            for (int r = 0; r < 16; ++r) { o[0][r] = 0.f; o[1][r] = 0.f; }
            const int jlow = br ? (cur >= 8 ? cur - 8 : 0) : 0;
            tile_stream_pair(cur,
                [&](int j) { if (br) return j > jlow ? j - 1 : -1;
                             if (j <= 0) return -1;
                             const int q = j - 1; int w = q >> 5; unsigned mk = (w == 0 ? un[0] : w == 1 ? un[1] : w == 2 ? un[2] : un[3]) & (0xffffffffu >> (31 - (q & 31)));
                             for (;;) { if (mk) return w * 32 + 31 - __builtin_clz(mk); if (--w < 0) return -1; mk = (w == 0 ? un[0] : w == 1 ? un[1] : un[2]); } },
                [&](int j, int sl) { dma_tile(kb + (size_t)(64 * j) * PW, vb + (size_t)(64 * j) * PW, PW, lds + sl * SLOT, wid, lane); },
                [&](int j, int sl) {
                    const bool mine = br ? true : (((selw[j >> 5] >> (j & 31)) & 1u) != 0u);
                    if (__any(mine)) {
                        const LAS unsigned char* kt = lds + sl * SLOT;
                        f32x16 p0, p1; qkt(p0, p1, kt, qr, r32, hi);
                        const int d0 = t - (64 * j + 4 * hi);
                        if (br ? (j < cur && j > cur - 8) : (j < cur)) {
                            const float b0 = -slope2 * (float)d0, b1 = b0 + 32.f * slope2;
                            float rm0 = -1e30f, rm1 = -1e30f;
#pragma unroll
                            for (int r = 0; r < 16; ++r) { p0[r] = p0[r] * scale2 + cK[r]; p1[r] = p1[r] * scale2 + cK[r]; rm0 = fmaxf(rm0, p0[r]); rm1 = fmaxf(rm1, p1[r]); }
                            float rm = fmaxf(rm0 + b0, rm1 + b1); rm = mine ? rm : -1e30f; rm = xmax32(rm);
                            const float mn = (rm > m + 8.f) ? rm : m, f = __builtin_amdgcn_exp2f(m - mn); m = mn;
                            const float off0 = mine ? mn - b0 : 1e30f, off1 = mine ? mn - b1 : 1e30f; float rs = 0.f;
#pragma unroll
                            for (int r = 0; r < 16; ++r) { p0[r] = __builtin_amdgcn_exp2f(p0[r] - off0); p1[r] = __builtin_amdgcn_exp2f(p1[r] - off1); rs += p0[r] + p1[r]; }
                            l = l * f + xsum32(rs);
                            if (__any(f != 1.f)) scale_rows(o, f, wsf, r32, hi);
                        } else {
#pragma unroll
                            for (int r = 0; r < 16; ++r) { const int d = d0 - ((r & 3) + 8 * (r >> 2)), e = d - 32;
                                const bool v0 = br ? (d >= 0 && d < 512) : (mine && d >= 0), v1 = br ? (e >= 0 && e < 512) : (mine && e >= 0);
                                p0[r] = v0 ? p0[r] * scale2 - slope2 * (float)d : -1e30f; p1[r] = v1 ? p1[r] * scale2 - slope2 * (float)e : -1e30f; }
                            softmax_step(p0, p1, m, l, o, wsf, r32, hi);
                        }
                        u32x4 pw[4]; pack_p(pw, p0, p1); pv(o, kt + 8192, pw, lane);
                    } });
            scale_rows(o, rep2_ ? 0.f : (l > 0.f ? 1.f / l : 0.f) * (br ? g2 : g1), wsf, r32, hi);
#pragma unroll
            for (int r = 0; r < 16; ++r) { LAS float* orow = stg + crow(r, hi) * 64 + r32; orow[0] += o[0][r]; orow[32] += o[1][r]; }
        }
    }
    issue_first(nx, pc, lds, wid, lane);
    { const size_t mb = (size_t)b * SEQ + pos0;
#pragma unroll
      for (int it = 0; it < 4; ++it) { const int row = 32 * wid + it * 8 + (lane >> 3), c8 = lane & 7, pq = row >> 2, hh = row & 3;
          const f32x4 a = *(const LAS f32x4*)(OA + row * 64 + c8 * 8), c = *(const LAS f32x4*)(OA + row * 64 + c8 * 8 + 4);
          const u32x4 z = zz[it];
          u32x4 w; w.x = cvt_pk_bf16(a.x * siluf_(bflo(z.x)), a.y * siluf_(bfhi(z.x))); w.y = cvt_pk_bf16(a.z * siluf_(bflo(z.y)), a.w * siluf_(bfhi(z.y)));
          w.z = cvt_pk_bf16(c.x * siluf_(bflo(z.z)), c.y * siluf_(bfhi(z.z))); w.w = cvt_pk_bf16(c.z * siluf_(bflo(z.w)), c.w * siluf_(bfhi(z.w)));
          *(u32x4*)(Y + (mb + pq) * DM + hh * 64 + c8 * 8) = w; } }
}
__device__ __forceinline__ void ustate_unit(const bf16* P, float* U, int unit, LAS unsigned char* lds, int tid) {
    asm volatile("" : "+v"(tid));
    const int lane = tid & 63, wid = __builtin_amdgcn_readfirstlane(tid >> 6), r32 = lane & 31, hi = lane >> 5;
    const int b = unit >> 7, h = (unit >> 5) & 3, pos0 = (unit & 31) * 256, ch = wid >> 2, dh = (wid >> 1) & 1, eh = wid & 1;
    const bf16* kb = P + ((size_t)b * SEQ + pos0) * PW + D_K + h * 64; const bf16* vb = P + ((size_t)b * SEQ + pos0) * PW + D_V + h * 64;
    const size_t roff = (size_t)(16 * (wid & 3) + (lane >> 2)) * PW + (wid >> 2) * 32 + (lane & 3) * 8;
#pragma unroll
    for (int tt = 0; tt < 4; ++tt) {
        __builtin_amdgcn_global_load_lds((const unsigned*)(kb + (size_t)(64 * tt) * PW + roff), (LAS unsigned*)(lds + tt * SLOT + wid * 1024), 16, 0, 0);
        __builtin_amdgcn_global_load_lds((const unsigned*)(vb + (size_t)(64 * tt) * PW + roff), (LAS unsigned*)(lds + tt * SLOT + 8192 + wid * 1024), 16, 0, 0); }
    FA_WAIT(0); FA_BAR();
    const float lg2 = __builtin_amdgcn_logf(1.f - exp2f(-5.f - (float)h));
    f32x16 acc;
#pragma unroll
    for (int r = 0; r < 16; ++r) acc[r] = 0.f;
    const int voff = ((lane >> 4) & 1) * 32 + (lane & 3) * 8 + (4 * hi + ((lane & 15) >> 2)) * 64;
#pragma unroll
    for (int t2 = 0; t2 < 2; ++t2) { const LAS unsigned char* kt = lds + (2 * ch + t2) * SLOT + voff;
#pragma unroll
        for (int ks = 0; ks < 4; ++ks) {
            const s16x4 klo = vtr(kt + dh * 4096 + ks * 1024), khi = vtr(kt + dh * 4096 + ks * 1024 + 512), vlo = vtr(kt + 8192 + eh * 4096 + ks * 1024), vhi = vtr(kt + 8192 + eh * 4096 + ks * 1024 + 512);
            const int jb = 64 * t2 + 16 * ks + 4 * hi; float kz[8];
#pragma unroll
            for (int e = 0; e < 4; ++e) { kz[e] = bf2f((bf16)klo[e]) * __builtin_amdgcn_exp2f(lg2 * (float)(127 - (jb + e))); kz[4 + e] = bf2f((bf16)khi[e]) * __builtin_amdgcn_exp2f(lg2 * (float)(127 - (jb + 8 + e))); }
            const u32x4 kw = (u32x4){cvt_pk_bf16(kz[0], kz[1]), cvt_pk_bf16(kz[2], kz[3]), cvt_pk_bf16(kz[4], kz[5]), cvt_pk_bf16(kz[6], kz[7])};
            const bf16x8 vf = (bf16x8){vlo[0], vlo[1], vlo[2], vlo[3], vhi[0], vhi[1], vhi[2], vhi[3]};
            acc = __builtin_amdgcn_mfma_f32_32x32x16_bf16(__builtin_bit_cast(bf16x8, kw), vf, acc, 0, 0, 0); } }
    float* ud = U + ((((size_t)b * 64 + (pos0 >> 7) + ch) * 4 + h) * 64 + 32 * dh) * 64 + 32 * eh + r32;
#pragma unroll
    for (int r = 0; r < 16; ++r) st_wt(ud + (size_t)crow(r, hi) * 64, acc[r]);
    FA_BAR();
}
}

typedef const __attribute__((address_space(4))) Args* KArgs;
#define PH_PTRS() KArgs kp = ka; asm volatile("" : "+s"(kp)); unsigned char* const ws = kp->ws; (void)ws; int tid = (wave << 6) | lane_id_now(); const int lane = tid & 63; (void)lane; int gwl = gw; asm volatile("" : "+s"(gwl)); (void)gwl
__global__ void __launch_bounds__(NTHREADS, 2) hybrid_fwd(Args args_byval) {
    extern __shared__ __attribute__((aligned(16))) unsigned char lds_raw[];
    LAS unsigned char* lds = (LAS unsigned char*)lds_raw;
    volatile LAS unsigned* MISC = (volatile LAS unsigned*)(lds + MISC_OFF);
    const KArgs ka = (KArgs)__builtin_amdgcn_kernarg_segment_ptr();
    const int tid0 = threadIdx.x, wave = __builtin_amdgcn_readfirstlane(tid0 >> 6);
    const int G = gridDim.x, gw = blockIdx.x * NWAVES + wave, NGW = G * NWAVES;
    const int vcu = (G % 8 == 0) ? ((int)blockIdx.x % 8) * (G / 8) + (int)blockIdx.x / 8 : (int)blockIdx.x;
    for (int u = tid0; u < (LDS_BYTES - LDSCTL_OFF) / 4; u += NTHREADS) ((LAS unsigned*)(lds + LDSCTL_OFF))[u] = 0u;
    __syncthreads();
    XcdBarrier bar; bar.bar = (unsigned*)(args_byval.ws + WS_CTL) + CW_BAR; bar.x = 0; bar.st = nullptr;
    if (MK_N_LAUNCHES == 1) bar = xcd_barrier_post(bar.bar, MISC + 8);
    bar.wave = wave;
#if MK_N_LAUNCHES == 1
#define IN(k) true
#else
    const int lo = args_byval.ph_lo, hi = args_byval.ph_hi;
#define IN(k) (lo <= (k) && (k) < hi)
#endif
#define SEAM(k) do { if (IN(k) && IN((k) + 1)) { if (MK_N_LAUNCHES == 1) { for (int rb_ = 0; rb_ < NREP(12); ++rb_) xcd_barrier(bar); } } } while (0)
    LAS float* wl = (LAS float*)(lds + wave * 8192);

    if (IN(0)) {
        PH_PTRS();
        bf16* WIN_T = (bf16*)(ws + WS_WIN); bf16* WCAT_T = (bf16*)(ws + WS_WCAT); bf16* WO_T = (bf16*)(ws + WS_WO); float* MOD = (float*)(ws + WS_MOD);
        LAS float* scr = (LAS float*)(lds + wave * 16384);
        constexpr int I_WIN = DEPTH * 16 * 120, I_G = 16 * 16 * 32, I_B = 16 * 4 * 32, I_O = DEPTH * 16 * 32, I_W1 = DEPTH * 2 * 32 * 2, I_P1 = DEPTH * 2 * 8;
        for (int rep_ = 0; rep_ < NREP(0); ++rep_)
        for (int it = gwl; it < I_WIN + I_G + I_B + I_O + I_W1 + I_P1; it += NGW) {
            int r = it;
            if (r >= I_WIN + I_G + I_B + I_O) { r -= I_WIN + I_G + I_B + I_O;
                if (r < I_W1) { const int mat = r >> 6, q = r & 63; transpose_item<false>(kp->cmp_w1 + (size_t)mat * 2048 * 64, 64, (bf16*)(ws + WS_W1T) + (size_t)mat * 64 * 2048, 2048, 0, scr, q >> 1, q & 1, lane); continue; }
                r -= I_W1; { const int mat = r >> 3, sl = r & 7; const float* w1 = kp->cmp_w1 + ((size_t)mat * 2048 + 256 * sl) * 64 + lane; const float* pos = kp->cmp_pos + (size_t)mat * 2048 + 256 * sl; float a = 0.f;
#pragma unroll 8
                    for (int i = 0; i < 256; ++i) a += pos[i] * w1[(size_t)i * 64];
                    ((float*)(ws + WS_B1P))[(mat * 8 + sl) * 64 + lane] = a; }
                continue; }
            if (r < I_WIN) { const int l = r / (16 * 120), q = r % (16 * 120); transpose_item<true>(kp->w_in + (size_t)l * DM * INW, INW, WIN_T + (size_t)l * PW * DM, DM, 0, scr, q / 120, q % 120, lane); continue; } r -= I_WIN;
            if (r < I_G) { const int li = r / 512, q = r % 512; transpose_item<false>(kp->w_merge + (size_t)li * DM * DM, DM, WCAT_T + (size_t)li * DM * KCAT, KCAT, 0, scr, q / 32, q % 32, lane); continue; } r -= I_G;
            if (r < I_B) { const int li = r / 128, q = r % 128; transpose_item<false>(kp->w_br + (size_t)li * 256 * DM, DM, WCAT_T + (size_t)li * DM * KCAT, KCAT, 1024, scr, q / 32, q % 32, lane); continue; } r -= I_B;
            { const int l = r / 512, q = r % 512; transpose_item<false>(kp->w_out + (size_t)l * DM * DM, DM, WO_T + (size_t)l * DM * DM, DM, 0, scr, q / 32, q % 32, lane); }
        }
        __syncthreads();
        LAS float* red = (LAS float*)lds;
        const float* cvec = kp->c;
        for (int rep_ = 0; rep_ < NREP(13); ++rep_)
        for (int u = blockIdx.x; u < DEPTH * 48; u += G) {
            const int l = u / 48, col = (u % 48) * 64 + lane; float a[4] = {0.f, 0.f, 0.f, 0.f};
            const float* wa = kp->w_ada + (size_t)l * DM * 3072 + col;
            for (int k0 = wave * 128; k0 < wave * 128 + 128; k0 += 16) { float wv[16];
#pragma unroll
                for (int i = 0; i < 16; ++i) wv[i] = wa[(size_t)(k0 + i) * 3072];
#pragma unroll
                for (int i = 0; i < 16; ++i)
#pragma unroll
                    for (int b = 0; b < 4; ++b) a[b] += siluf_(cvec[b * DM + k0 + i]) * wv[i]; }
#pragma unroll
            for (int b = 0; b < 4; ++b) red[(wave * 4 + b) * 64 + lane] = a[b];
            __syncthreads();
            if (wave < 4) { float s = kp->b_ada[(size_t)l * 3072 + col];
#pragma unroll
                for (int w = 0; w < 8; ++w) s += red[(w * 4 + wave) * 64 + lane];
                MOD[((size_t)l * 4 + wave) * 3072 + col] = s; }
            __syncthreads();
        }
    }
    SEAM(0);
    if (IN(1)) {
        PH_PTRS();
        const float* MOD = (const float*)(ws + WS_MOD);
        float* GS = (float*)(ws + WS_GS);
        for (int idx = blockIdx.x * NTHREADS + tid; idx < DEPTH * NBATCH * DM; idx += G * NTHREADS) { const int lb = idx >> 10, c = idx & 1023; GS[idx] = kp->norm_g[(lb >> 2) * DM + c] * (1.f + MOD[(size_t)lb * 3072 + 1024 + c]); }
        constexpr int T_IN = DEPTH * PW, T_MG = DEPTH * 4096;
        for (int tb = 4 * gwl; tb < T_IN + T_MG; tb += 4 * NGW) {
            u32x4 w0[4], w1[4];
#pragma unroll
            for (int q = 0; q < 4; ++q) { const int task = tb + q; const bf16* wrow;
                if (task < T_IN) wrow = (const bf16*)(ws + WS_WIN) + (size_t)task * DM; else wrow = (const bf16*)(ws + WS_WCAT) + (size_t)(task - T_IN) * KCAT;
                w0[q] = *(const u32x4*)(wrow + 8 * lane); w1[q] = *(const u32x4*)(wrow + 512 + 8 * lane); }
#pragma unroll
            for (int q = 0; q < 4; ++q) { const int task = tb + q; int l, n; float* dst; int dpitch;
                if (task < T_IN) { l = task / PW; n = task % PW; dst = (float*)(ws + WS_SW) + (size_t)l * NBATCH * PW + n; dpitch = PW; }
                else { const int qq = task - T_IN; l = qq >> 12; n = qq & 4095; dst = (float*)(ws + WS_SWM) + (size_t)l * NBATCH * 4096 + n; dpitch = 4096; }
                const float wv[16] = {bflo(w0[q].x), bfhi(w0[q].x), bflo(w0[q].y), bfhi(w0[q].y), bflo(w0[q].z), bfhi(w0[q].z), bflo(w0[q].w), bfhi(w0[q].w), bflo(w1[q].x), bfhi(w1[q].x), bflo(w1[q].y), bfhi(w1[q].y), bflo(w1[q].z), bfhi(w1[q].z), bflo(w1[q].w), bfhi(w1[q].w)};
#pragma unroll
                for (int b = 0; b < NBATCH; ++b) { const float* sh = MOD + ((size_t)l * 4 + b) * 3072; float a = 0.f;
                    const f32x4 a0 = *(const f32x4*)(sh + 8 * lane), a1 = *(const f32x4*)(sh + 8 * lane + 4), a2 = *(const f32x4*)(sh + 512 + 8 * lane), a3 = *(const f32x4*)(sh + 512 + 8 * lane + 4);
                    a += wv[0] * a0.x + wv[1] * a0.y + wv[2] * a0.z + wv[3] * a0.w + wv[4] * a1.x + wv[5] * a1.y + wv[6] * a1.z + wv[7] * a1.w;
                    a += wv[8] * a2.x + wv[9] * a2.y + wv[10] * a2.z + wv[11] * a2.w + wv[12] * a3.x + wv[13] * a3.y + wv[14] * a3.z + wv[15] * a3.w;
                    a = wave_sum(a); if (lane == 0) dst[(size_t)b * dpitch] = a; } }
        }
        { const float* x = kp->x; const float* g = kp->norm_g; bf16* XN = (bf16*)(ws + WS_XN); float* SSQ = (float*)(ws + WS_SSQ);
          for (int m = gwl; m < MROWS; m += NGW) {
              const int b = m >> 13; const f32x4* xr = (const f32x4*)(x + (size_t)m * DM) + lane; f32x4 v[4]; float ss = 0.f;
#pragma unroll
              for (int j = 0; j < 4; ++j) { v[j] = xr[64 * j]; ss += v[j].x * v[j].x + v[j].y * v[j].y + v[j].z * v[j].z + v[j].w * v[j].w; }
              ss = wave_sum(ss); if (lane == 0) *(f32x4*)(SSQ + (size_t)m * 4) = (f32x4){ss, 0.f, 0.f, 0.f};
              u32x2* o8 = (u32x2*)(XN + (size_t)m * DM) + lane;
#pragma unroll
              for (int j = 0; j < 4; ++j) { const int col = 4 * (lane + 64 * j); const f32x4 gg = *(const f32x4*)(g + col), sc = *(const f32x4*)(MOD + (size_t)b * 3072 + 1024 + col);
                  const f32x4 hh = v[j] * gg * (sc + 1.f); u32x2 w; w.x = pk2(hh.x, hh.y); w.y = pk2(hh.z, hh.w); o8[64 * j] = w; } } }
    }
    SEAM(1);

    for (int l = 0; l < DEPTH; ++l) {
        const int pb = 2 + l * PH_PER_LAYER - 1;
        if (IN(pb + 1)) {
            PH_PTRS();
            pg8::PlainOrderT<WGM_G1, MROWS / 256, PW / 256> S{(const char*)(ws + WS_XN), (const char*)(ws + WS_WIN) + (size_t)l * PW * DM * 2, 16, G, (int)blockIdx.x, (size_t)DM, (size_t)DM};
            pg8::EpiP E{(bf16*)(ws + WS_P), (const float*)(ws + WS_SSQ), (const float*)(ws + WS_SW) + (size_t)l * NBATCH * PW, lds + L_GSLOT};
            if (DBG_REP == 0 && (int)blockIdx.x + 7 * G >= (MROWS / 256) * (PW / 256)) { for (int zz = 0; zz < GEMM1_SKEW; ++zz) __builtin_amdgcn_s_sleep(127); }
            for (int rep_ = 0; rep_ < NREP(2); ++rep_) { pg8::gemm_phase<pg8::EpiP, pg8::PlainOrderT<WGM_G1, MROWS / 256, PW / 256>, true>(lds, DM, DM, S, E, tid); }
            if (NREP(18) > 1) { pg8::EpiNull EN{(float*)(ws + WS_Y)}; pg8::gemm_phase<pg8::EpiNull, pg8::PlainOrderT<WGM_G1, MROWS / 256, PW / 256>, true>(lds, DM, DM, S, EN, tid); }
        }
        SEAM(pb + 1);
        if (IN(pb + 2)) {
            PH_PTRS();
            const bf16* P = (const bf16*)(ws + WS_P); bf16* Y = (bf16*)(ws + WS_Y); float* U = (float*)(ws + WS_U);
            unsigned* cnts = (unsigned*)(ws + WS_CTL) + CW_CNT + l * 4 * 64; (void)cnts;
            for (int rep_ = 0; rep_ < NREP(3); ++rep_)
            for (int u = blockIdx.x; u < 64; u += G) {
                const int jj = u >> 5, b = (u >> 3) & 3, c0 = (u & 7) * 32, mat = l * 2 + jj, r32 = lane & 31, hi = lane >> 5;
                __syncthreads();
                fa::f32x16 acc[2];
#pragma unroll
                for (int r = 0; r < 16; ++r) { acc[0][r] = 0.f; acc[1][r] = 0.f; }
                const bf16* zrow = P + ((size_t)b * SEQ + (size_t)(c0 + r32) * 32 + 4 * wave) * PW + A_KV + 64 * jj + 8 * hi;
                const bf16* wrow = (const bf16*)(ws + WS_W1T) + ((size_t)mat * 64 + r32) * 2048 + 256 * wave + 8 * hi;
#pragma unroll 4
                for (int ks = 0; ks < 16; ++ks) {
                    const bf16x8 af = *(const bf16x8*)(zrow + (size_t)(ks >> 2) * PW + 16 * (ks & 3));
                    const bf16x8 b0 = *(const bf16x8*)(wrow + 16 * ks), b1 = *(const bf16x8*)(wrow + 32 * 2048 + 16 * ks);
                    acc[0] = __builtin_amdgcn_mfma_f32_32x32x16_bf16(af, b0, acc[0], 0, 0, 0); acc[1] = __builtin_amdgcn_mfma_f32_32x32x16_bf16(af, b1, acc[1], 0, 0, 0); }
                LAS float* red = (LAS float*)lds + wave * 2048;
#pragma unroll
                for (int r = 0; r < 16; ++r) { const int row = fa::crow(r, hi); red[row * 64 + r32] = acc[0][r]; red[row * 64 + 32 + r32] = acc[1][r]; }
                __syncthreads();
                LAS float* hidL = (LAS float*)(lds + 65536);
                const float* b1p = (const float*)(ws + WS_B1P) + mat * 512;
#pragma unroll
                for (int q = 0; q < 4; ++q) { const int idx = tid + 512 * q, e = idx & 63; float sacc = 0.f;
#pragma unroll
                    for (int w = 0; w < 8; ++w) sacc += ((LAS float*)lds)[w * 2048 + idx] + b1p[w * 64 + e];
                    hidL[idx] = siluf_(sacc); }
                __syncthreads();
                LAS float* w2L = (LAS float*)(lds + 65536 + 8192);
                { const float* w2 = kp->cmp_w2 + (size_t)mat * 4096; const f32x4 wa = *(const f32x4*)(w2 + 8 * tid), wb = *(const f32x4*)(w2 + 8 * tid + 4);
                  *(LAS f32x4*)(w2L + 8 * tid) = wa; *(LAS f32x4*)(w2L + 8 * tid + 4) = wb; }
                __syncthreads();
#pragma unroll
                for (int q = 0; q < 2; ++q) { const int idx = tid + 512 * q, row = idx >> 5, e = 2 * (idx & 31); float o0 = 0.f, o1 = 0.f;
#pragma unroll 8
                    for (int d = 0; d < 64; ++d) { const f32x2 w = *(const LAS f32x2*)(w2L + d * 64 + e); const float hv = hidL[row * 64 + d]; o0 += hv * w.x; o1 += hv * w.y; }
                    st_wt((unsigned*)((bf16*)(ws + (jj ? WS_VCB : WS_KCB)) + ((size_t)b * 256 + c0 + row) * 64 + e), pk2(o0, o1)); }
            }
            if (MIX_MERGE) { if (blockIdx.x < 64) publish_count(cnts + 0 * 64, tid == 0); }
            __syncthreads();
            for (int rep_ = 0; rep_ < NREP(4); ++rep_) { if (G > 128) { if ((int)blockIdx.x >= 64) for (int u = (int)blockIdx.x - 64; u < 512; u += G - 64) fa::ustate_unit(P, U, u, lds, tid); } else { for (int u = vcu; u < 512; u += G) fa::ustate_unit(P, U, u, lds, tid); } }
            if (MIX_MERGE) publish_count(cnts + 1 * 64, tid == 0); else __syncthreads();
            const float* sink = kp->sink + l * 4;
            const fa::PreCtx pc{P, (const bf16*)(ws + WS_KCB), (const bf16*)(ws + WS_VCB), (const float*)(ws + WS_U)}; const fa::NextUnit none{fa::K_NONE, 0, false};
            bool pre = false;
            for (int rep_ = 0; rep_ < NREP(5); ++rep_) { for (int u = vcu; u < 512; u += G) { const fa::NextUnit nx = !XPRE ? none : (u + G < 512) ? fa::NextUnit{fa::K_SWA, u + G, false} : fa::NextUnit{fa::K_STICK, vcu, false};
                fa::swa_unit(P, sink, Y, u, lds, tid, pre, nx, pc); pre = XPRE; } }
            for (int rep_ = 0; rep_ < NREP(6); ++rep_) { for (int u = vcu; u < 512; u += G) { const fa::NextUnit nx = !XPRE ? none : (u + G < 512) ? fa::NextUnit{fa::K_STICK, u + G, false} : fa::NextUnit{fa::K_NSA_TOUCH, vcu, false};
                fa::stick_unit(P, Y, u, lds, tid, pre, nx, pc); pre = XPRE && (u + G < 512); } }
        }
        if (!MIX_MERGE) SEAM(pb + 2);
        if (IN(pb + 3)) {
            PH_PTRS();
            float* U = (float*)(ws + WS_U);
            unsigned* cnts = (unsigned*)(ws + WS_CTL) + CW_CNT + l * 4 * 64; (void)cnts;
            if (MIX_MERGE) wait_count(cnts + 1 * 64, (unsigned)G, wave);
            for (int gid = blockIdx.x * NTHREADS + tid; gid < 65536; gid += G * NTHREADS) {
                const int bh = gid >> 12, b = bh >> 2, h = bh & 3, de = gid & 4095;
                const float gch = __expf(logf(1.f - exp2f(-5.f - (float)h)) * 128.f); float r = 0.f;
                float* up = U + (((size_t)b * 64) * 4 + h) * 4096 + de;
                for (int n0 = 0; n0 < 64; n0 += 32) { float uv[32];
#pragma unroll
                    for (int i = 0; i < 32; ++i) uv[i] = up[(size_t)(n0 + i) * 4 * 4096];
#pragma unroll
                    for (int i = 0; i < 32; ++i) { st_wt(up + (size_t)(n0 + i) * 4 * 4096, r); r = r * gch + uv[i]; } }
            }
            if (MIX_MERGE) { publish_count(cnts + 2 * 64, tid == 0); wait_count(cnts + 0 * 64, 64u, wave); } else __syncthreads();
            const fa::PreCtx pc{(const bf16*)(ws + WS_P), (const bf16*)(ws + WS_KCB), (const bf16*)(ws + WS_VCB), (const float*)(ws + WS_U)}; const fa::NextUnit none{fa::K_NONE, 0, false};
            bool pre = false;
            for (int rep_ = 0; rep_ < NREP(7); ++rep_) { for (int u = vcu; u < 512; u += G) { const fa::NextUnit nx = !XPRE ? none : (u + G < 512) ? fa::NextUnit{fa::K_NSA, u + G, false} : fa::NextUnit{fa::K_RET, vcu, false};
                fa::nsa_unit(pc.P, pc.KCB, pc.VCB, (bf16*)(ws + WS_Y), u, lds, tid, pre, nx, pc); pre = XPRE; } }
        }
        if (!MIX_MERGE) SEAM(pb + 3);
        if (IN(pb + 4)) {
            PH_PTRS();
            if (MIX_MERGE) wait_count((unsigned*)(ws + WS_CTL) + CW_CNT + (l * 4 + 2) * 64, (unsigned)G, wave);
            const fa::PreCtx pc{(const bf16*)(ws + WS_P), (const bf16*)(ws + WS_KCB), (const bf16*)(ws + WS_VCB), (const float*)(ws + WS_U)}; const fa::NextUnit none{fa::K_NONE, 0, false};
            bool pre = XPRE;
            for (int rep_ = 0; rep_ < NREP(8); ++rep_) { for (int u = vcu; u < 512; u += G) { const fa::NextUnit nx = (XPRE && u + G < 512) ? fa::NextUnit{fa::K_RET, u + G, true} : none;
                fa::ret_unit(pc.P, pc.R, (bf16*)(ws + WS_Y), u, lds, tid, pre, nx, pc); pre = XPRE && (u + G < 512); } }
        }
        SEAM(pb + 4);
        if (IN(pb + 5)) {
            PH_PTRS();
            pg8::PostOrder S{(const char*)(ws + WS_XN), (const char*)(ws + WS_Y), (const char*)(ws + WS_WCAT) + (size_t)l * 4 * DM * KCAT * 2, G, (int)blockIdx.x};
            pg8::EpiPost E{(bf16*)(ws + WS_MERGED), (u32x4*)(ws + WS_SCR + (size_t)blockIdx.x * 262144), (const float*)(ws + WS_SSQ), (const float*)(ws + WS_SWM) + (size_t)l * NBATCH * 4096, lds + L_GSLOT, tid};
            for (int rep_ = 0; rep_ < NREP(9); ++rep_) { pg8::gemm_phase<pg8::EpiPost, pg8::PostOrder, true>(lds, DM, KCAT, S, E, tid); }
            if (NREP(17) > 1) { pg8::EpiNull EN{(float*)(ws + WS_P + 200 * MiB)}; pg8::gemm_phase<pg8::EpiNull, pg8::PostOrder, true>(lds, DM, KCAT, S, EN, tid); }
        }
        SEAM(pb + 5);
        if (IN(pb + 6)) {
            PH_PTRS();
            pg8::PlainOrderT<WGM_OUT, MROWS / 256, DM / 256> S{(const char*)(ws + WS_MERGED), (const char*)(ws + WS_WO) + (size_t)l * DM * DM * 2, 16, G, (int)blockIdx.x, (size_t)DM, (size_t)DM};
            bf16* XB = (bf16*)((char*)kp->out + 64 * MiB);
            bf16* XF = (bf16*)(ws + WS_XF);
            const float* gate = (const float*)(ws + WS_MOD) + (size_t)l * 4 * 3072 + 2048; const float* gsn = (l + 1 < DEPTH) ? (const float*)(ws + WS_GS) + (size_t)(l + 1) * NBATCH * DM : (const float*)nullptr;
            if (l == 0) { pg8::EpiOutT<false, true> E{kp->x, XB, XB, gate, (bf16*)(ws + WS_XN), gsn, (float*)(ws + WS_SSQ), (LAS float*)(lds + 132096), tid};
                pg8::gemm_phase<pg8::EpiOutT<false, true>, pg8::PlainOrderT<WGM_OUT, MROWS / 256, DM / 256>, true>(lds, DM, DM, S, E, tid); }
            else { pg8::EpiOutT<true, true> E{kp->x, XB, (l + 1 < DEPTH) ? XB : XF, gate, (bf16*)(ws + WS_XN), gsn, (float*)(ws + WS_SSQ), (LAS float*)(lds + 132096), tid};
                pg8::gemm_phase<pg8::EpiOutT<true, true>, pg8::PlainOrderT<WGM_OUT, MROWS / 256, DM / 256>, true>(lds, DM, DM, S, E, tid); }
            if (NREP(19) > 1) { pg8::EpiNull EN{(float*)(ws + WS_P + 200 * MiB)}; pg8::gemm_phase<pg8::EpiNull, pg8::PlainOrderT<WGM_OUT, MROWS / 256, DM / 256>, true>(lds, DM, DM, S, EN, tid); }
        }
        SEAM(pb + 6);
    }
    if (IN(NPH - 1)) {
        PH_PTRS();
        float* out = kp->out; const float* fg = kp->final_g; const bf16* xf = (const bf16*)(ws + WS_XF);
        for (int m = gwl; m < MROWS; m += NGW) {
            const u32x4* xi = (const u32x4*)(xf + (size_t)m * DM) + lane; f32x4 v[4]; float ss = 0.f;
#pragma unroll
            for (int j = 0; j < 2; ++j) { const u32x4 w = xi[64 * j]; v[2 * j] = (f32x4){bflo(w.x), bfhi(w.x), bflo(w.y), bfhi(w.y)}; v[2 * j + 1] = (f32x4){bflo(w.z), bfhi(w.z), bflo(w.w), bfhi(w.w)}; }
#pragma unroll
            for (int j = 0; j < 4; ++j) ss += v[j].x * v[j].x + v[j].y * v[j].y + v[j].z * v[j].z + v[j].w * v[j].w;
            const float r = rsqrtf(wave_sum(ss) * (1.f / DM) + 1e-6f);
#pragma unroll
            for (int j = 0; j < 4; ++j) { const int c4 = 128 * (j >> 1) + 2 * lane + (j & 1); const f32x4 gg = *(const f32x4*)(fg + 4 * c4); *((f32x4*)(out + (size_t)m * DM) + c4) = (v[j] * r) * gg; }
        }
    }
#undef IN
#undef SEAM
}

extern "C" void kernel_launch(void* const* d_in, const int* in_sizes, int n_in, void* d_out, int out_size, void* d_ws, size_t ws_size, hipStream_t stream) {
    static int grid = 0;
    if (grid == 0) {
        if (n_in != 14 || out_size != MROWS * DM || ws_size < WS_END) { fprintf(stderr, "kernel_launch: unexpected problem (n_in %d, out %d, ws %zu)\n", n_in, out_size, ws_size); grid = -1; return; }
        int dev = 0, cus = 0, per_cu = 0;
        if (hipGetDevice(&dev) != hipSuccess || hipDeviceGetAttribute(&cus, hipDeviceAttributeMultiprocessorCount, dev) != hipSuccess) { grid = -1; return; }
        if (hipFuncSetAttribute((const void*)hybrid_fwd, hipFuncAttributeMaxDynamicSharedMemorySize, LDS_BYTES) != hipSuccess) { fprintf(stderr, "kernel_launch: hipFuncSetAttribute failed\n"); grid = -1; return; }
        if (hipOccupancyMaxActiveBlocksPerMultiprocessor(&per_cu, (const void*)hybrid_fwd, NTHREADS, LDS_BYTES) != hipSuccess || per_cu < 1) fprintf(stderr, "kernel_launch: occupancy query reports %d\n", per_cu);
        (void)hipGetLastError();
        grid = cus;
    }
    if (grid < 0) return;
    if (hipMemsetAsync((char*)d_ws + WS_CTL, 0, CTL_ZERO_BYTES, stream) != hipSuccess) return;
    Args a{};
    a.x = (const float*)d_in[0]; a.c = (const float*)d_in[1]; a.w_ada = (const float*)d_in[2]; a.b_ada = (const float*)d_in[3]; a.norm_g = (const float*)d_in[4]; a.w_in = (const float*)d_in[5];
    a.cmp_pos = (const float*)d_in[6]; a.cmp_w1 = (const float*)d_in[7]; a.cmp_w2 = (const float*)d_in[8]; a.sink = (const float*)d_in[9]; a.w_merge = (const float*)d_in[10]; a.w_br = (const float*)d_in[11];
    a.w_out = (const float*)d_in[12]; a.final_g = (const float*)d_in[13];
    a.out = (float*)d_out; a.ws = (unsigned char*)d_ws;
    if (MK_N_LAUNCHES == 1) { a.ph_lo = 0; a.ph_hi = NPH; a.li = 0; hipLaunchKernelGGL(hybrid_fwd, dim3(grid), dim3(NTHREADS), LDS_BYTES, stream, a); }
    else for (int p = 0; p < NPH; ++p) { a.ph_lo = p; a.ph_hi = p + 1; a.li = p; hipLaunchKernelGGL(hybrid_fwd, dim3(grid), dim3(NTHREADS), LDS_BYTES, stream, a); }
}
```
